# Optimizing an MI355X kernel written in HIP

```python
import jax, jax.numpy as jnp
from jax import lax
import numpy as np

D_MODEL = 2048
BATCH = 2
SEQ = 4096
DEPTH = 1

ATT_HEADS = 8
ATT_HEAD_DIM = 128
ATT_WIDTH = ATT_HEADS * ATT_HEAD_DIM
RWKV_WIDTH = D_MODEL - ATT_WIDTH
RWKV_HEAD_DIM = 64
RWKV_HEADS = RWKV_WIDTH // RWKV_HEAD_DIM
IDX_HEADS = 16
IDX_HEAD_DIM = 64
TOPK_MAX = 256
ROPE_THETA = 500000.0
ROPE_FRACTION = 4
DECAY_LORA = 96
AAA_LORA = 96
GATE_LORA = 256
D_FF = ((8 * D_MODEL // 3 + 255) // 256) * 256
Q_BLOCK = 64
NORM_EPS = 1e-6
LNX_EPS = 64e-5

ATT_SPLITS = (ATT_WIDTH, ATT_WIDTH, ATT_WIDTH, IDX_HEADS * IDX_HEAD_DIM, IDX_HEAD_DIM, IDX_HEADS)
RWKV_SPLITS = (RWKV_WIDTH, RWKV_WIDTH, RWKV_WIDTH, DECAY_LORA, AAA_LORA, GATE_LORA)
ATT_COLS = sum(ATT_SPLITS)
RWKV_COLS = sum(RWKV_SPLITS)
IN_COLS = ATT_COLS + RWKV_COLS

kernel_name = "hymba_dsa_rwkv7_adaln_layer"


def split_cols(y, sizes):
    offs = [int(o) for o in np.cumsum(sizes)[:-1]]
    return jnp.split(y, offs, axis=-1)


def rms_norm(x, gain):
    xf = x.astype(jnp.float32)
    y = xf * lax.rsqrt(jnp.mean(xf * xf, axis=-1, keepdims=True) + NORM_EPS)
    return (y * gain.astype(jnp.float32)).astype(x.dtype)


def partial_rope(x, positions):
    d = x.shape[-1]
    rot = d // ROPE_FRACTION
    half = rot // 2
    inv_freq = ROPE_THETA ** (-jnp.arange(half, dtype=jnp.float32) / half)
    ang = positions.astype(jnp.float32)[..., None] * inv_freq
    cos = jnp.cos(ang)[:, :, None, :]
    sin = jnp.sin(ang)[:, :, None, :]
    xr = x[..., :rot].astype(jnp.float32)
    x1, x2 = xr[..., :half], xr[..., half:]
    rotated = jnp.concatenate([x1 * cos - x2 * sin, x2 * cos + x1 * sin], axis=-1)
    return jnp.concatenate([rotated.astype(x.dtype), x[..., rot:]], axis=-1)


def dsa_sparse_attention(q, k, v, iq, ik, iw):
    B, S, H, D = q.shape
    topk = min(TOPK_MAX, S // 4)
    nblk = S // Q_BLOCK
    key_pos = jnp.arange(S)
    bidx = jnp.arange(B)[:, None, None]

    def blocks(t):
        return jnp.moveaxis(t.reshape(B, nblk, Q_BLOCK, *t.shape[2:]), 1, 0)

    def one_block(args):
        bi, qb, iqb, iwb = args
        qpos = bi * Q_BLOCK + jnp.arange(Q_BLOCK)
        causal = key_pos[None, None, :] <= qpos[None, :, None]
        dots = jnp.einsum('bqhd,bsd->bqhs', iqb, ik, preferred_element_type=jnp.float32)
        score = jnp.einsum('bqhs,bqh->bqs', jax.nn.relu(dots), iwb.astype(jnp.float32))
        score = jnp.where(causal, score, -jnp.inf)
        _, idx = lax.top_k(score, topk)
        valid = idx <= qpos[None, :, None]
        k_sel = k[bidx, idx]
        v_sel = v[bidx, idx]
        logits = jnp.einsum('bqhd,bqkhd->bhqk', qb, k_sel,
                            preferred_element_type=jnp.float32) * (D ** -0.5)
        logits = jnp.where(valid[:, None], logits, -jnp.inf)
        p = jax.nn.softmax(logits, axis=-1).astype(v.dtype)
        return jnp.einsum('bhqk,bqkhd->bqhd', p, v_sel)

    out = lax.map(one_block, (jnp.arange(nblk), blocks(q), blocks(iq), blocks(iw)))
    return jnp.moveaxis(out, 0, 1).reshape(B, S, H * D)


def rwkv7_time_mix(y, mu, w0, w_up, a0, a_up, g_up, k_k, k_a, r_k, lnx_g, lnx_b):
    B, S, _ = y.shape
    H, N = RWKV_HEADS, RWKV_HEAD_DIM
    f32 = jnp.float32
    y_prev = jnp.pad(y, ((0, 0), (1, 0), (0, 0)))[:, :-1]
    y = y + (y_prev - y) * mu
    r, k, v, xw, xa, xg = split_cols(y, RWKV_SPLITS)
    w_raw = (w0 + jnp.tanh(xw) @ w_up).astype(f32)
    decay = jnp.exp(-jnp.exp(-jax.nn.softplus(-w_raw) - 0.5))
    a = jax.nn.sigmoid(a0 + xa @ a_up)
    g = jax.nn.sigmoid(xg) @ g_up

    def heads(t):
        return t.reshape(B, S, H, N)

    kk = heads(k * k_k).astype(f32)
    kk = kk / jnp.maximum(jnp.sqrt(jnp.sum(kk * kk, axis=-1, keepdims=True)), 1e-12)
    k = k * (1 + (a - 1) * k_a)
    r_h, k_h, v_h, a_h, w_h = heads(r), heads(k), heads(v), heads(a), heads(decay)

    def step(state, inp):
        r_t, w_t, k_t, v_t, kk_t, a_t = inp
        sa = jnp.einsum('bhvk,bhk->bhv', state, -kk_t)
        state = (state * w_t[:, :, None, :]
                 + sa[..., None] * (kk_t * a_t)[:, :, None, :]
                 + v_t[..., None] * k_t[:, :, None, :])
        out = jnp.einsum('bhvk,bhk->bhv', state, r_t)
        return state, out

    def seq_major(t):
        return jnp.moveaxis(t.astype(f32), 1, 0)

    state0 = jnp.zeros((B, H, N, N), f32)
    _, o = lax.scan(step, state0, (seq_major(r_h), seq_major(w_h), seq_major(k_h),
                                   seq_major(v_h), seq_major(kk), seq_major(a_h)))
    o = jnp.moveaxis(o, 0, 1)
    mean = jnp.mean(o, axis=-1, keepdims=True)
    var = jnp.mean(jnp.square(o - mean), axis=-1, keepdims=True)
    o = ((o - mean) * lax.rsqrt(var + LNX_EPS)).reshape(B, S, H * N) * lnx_g + lnx_b
    bonus = jnp.sum(r_h * k_h * r_k, axis=-1, keepdims=True) * v_h
    o = o + bonus.reshape(B, S, H * N)
    return (o * g).astype(y.dtype)


def setup_inputs(seed: int = 0) -> dict:
    key = jax.random.key(seed)
    ks = jax.random.split(key, 26)
    f32 = jnp.float32
    L = DEPTH

    def nrm(k, shape, scale):
        return jax.random.normal(k, shape, f32) * scale

    offset = jax.random.randint(ks[2], (BATCH, 1), 0, 1024, dtype=jnp.int32)
    return {
        "x": nrm(ks[0], (BATCH, SEQ, D_MODEL), 1.0),
        "c": nrm(ks[1], (BATCH, D_MODEL), 1.0),
        "positions": offset + jnp.arange(SEQ, dtype=jnp.int32)[None, :],
        "w_ada": nrm(ks[3], (L, D_MODEL, 6 * D_MODEL), D_MODEL ** -0.5),
        "b_ada": nrm(ks[4], (L, 6 * D_MODEL), 0.01),
        "norm1_g": 1.0 + nrm(ks[5], (L, D_MODEL), 0.02),
        "w_in": nrm(ks[6], (L, D_MODEL, IN_COLS), D_MODEL ** -0.5),
        "q_norm_g": 1.0 + nrm(ks[7], (L, ATT_HEAD_DIM), 0.02),
        "k_norm_g": 1.0 + nrm(ks[8], (L, ATT_HEAD_DIM), 0.02),
        "rwkv_mu": jax.random.uniform(ks[9], (L, RWKV_COLS), f32),
        "rwkv_w0": nrm(ks[10], (L, RWKV_WIDTH), 0.5),
        "rwkv_w_up": nrm(ks[11], (L, DECAY_LORA, RWKV_WIDTH), DECAY_LORA ** -0.5),
        "rwkv_a0": nrm(ks[12], (L, RWKV_WIDTH), 0.1),
        "rwkv_a_up": nrm(ks[13], (L, AAA_LORA, RWKV_WIDTH), AAA_LORA ** -0.5),
        "rwkv_g_up": nrm(ks[14], (L, GATE_LORA, RWKV_WIDTH), GATE_LORA ** -0.5),
        "rwkv_k_k": 0.85 + nrm(ks[15], (L, RWKV_WIDTH), 0.02),
        "rwkv_k_a": 1.0 + nrm(ks[16], (L, RWKV_WIDTH), 0.02),
        "rwkv_r_k": nrm(ks[17], (L, RWKV_HEADS, RWKV_HEAD_DIM), 0.1),
        "rwkv_lnx_g": 1.0 + nrm(ks[18], (L, RWKV_WIDTH), 0.02),
        "rwkv_lnx_b": nrm(ks[19], (L, RWKV_WIDTH), 0.01),
        "w_out": nrm(ks[20], (L, ATT_WIDTH + RWKV_WIDTH, D_MODEL), D_MODEL ** -0.5),
        "norm2_g": 1.0 + nrm(ks[21], (L, D_MODEL), 0.02),
        "w_ffn_gate": nrm(ks[22], (L, D_MODEL, D_FF), D_MODEL ** -0.5),
        "w_ffn_up": nrm(ks[23], (L, D_MODEL, D_FF), D_MODEL ** -0.5),
        "w_ffn_down": nrm(ks[24], (L, D_FF, D_MODEL), D_FF ** -0.5),
    }


def reference(x, c, positions, w_ada, b_ada, norm1_g, w_in, q_norm_g, k_norm_g,
              rwkv_mu, rwkv_w0, rwkv_w_up, rwkv_a0, rwkv_a_up, rwkv_g_up,
              rwkv_k_k, rwkv_k_a, rwkv_r_k, rwkv_lnx_g, rwkv_lnx_b, w_out,
              norm2_g, w_ffn_gate, w_ffn_up, w_ffn_down):
    B, S, _ = x.shape
    c_act = jax.nn.silu(c)
    for l in range(DEPTH):
        mod = c_act @ w_ada[l] + b_ada[l]
        sh1, sc1, gt1, sh2, sc2, gt2 = jnp.split(mod[:, None, :], 6, axis=-1)

        h = rms_norm(x, norm1_g[l]) * (1 + sc1) + sh1
        proj = h @ w_in[l]
        att_proj, rwkv_proj = proj[..., :ATT_COLS], proj[..., ATT_COLS:]
        q, k, v, iq, ik, iw = split_cols(att_proj, ATT_SPLITS)
        q = partial_rope(rms_norm(q.reshape(B, S, ATT_HEADS, ATT_HEAD_DIM), q_norm_g[l]), positions)
        k = partial_rope(rms_norm(k.reshape(B, S, ATT_HEADS, ATT_HEAD_DIM), k_norm_g[l]), positions)
        v = v.reshape(B, S, ATT_HEADS, ATT_HEAD_DIM)
        iq = partial_rope(iq.reshape(B, S, IDX_HEADS, IDX_HEAD_DIM), positions) * (IDX_HEAD_DIM ** -0.5)
        ik = partial_rope(ik[:, :, None, :], positions)[:, :, 0, :]
        iw = iw * (IDX_HEADS ** -0.5)
        att_out = dsa_sparse_attention(q, k, v, iq, ik, iw)
        rwkv_out = rwkv7_time_mix(rwkv_proj, rwkv_mu[l], rwkv_w0[l], rwkv_w_up[l],
                                  rwkv_a0[l], rwkv_a_up[l], rwkv_g_up[l], rwkv_k_k[l],
                                  rwkv_k_a[l], rwkv_r_k[l], rwkv_lnx_g[l], rwkv_lnx_b[l])
        mixed = jnp.concatenate([att_out, rwkv_out], axis=-1) @ w_out[l]
        x = x + gt1 * mixed

        h2 = rms_norm(x, norm2_g[l]) * (1 + sc2) + sh2
        ffn = (jax.nn.silu(h2 @ w_ffn_gate[l]) * (h2 @ w_ffn_up[l])) @ w_ffn_down[l]
        x = x + gt2 * ffn
    return x
```

```cpp
#include <hip/hip_runtime.h>
#include <hip/hip_cooperative_groups.h>
#include <cstdio>
#include <cstdint>
namespace cg = cooperative_groups;

constexpr int NB = 2, SEQ = 4096, T = NB * SEQ, DM = 2048, DFF = 5632;
constexpr int IN_COLS = 7696, NP = 7936;
constexpr int P_Q = 0, P_K = 1024, P_V = 2048, P_IQ = 3072, P_R = 4096, P_RK = 5120, P_RV = 6144, P_IK = 7168, P_IW = 7232, P_XW = 7296, P_XA = 7424, P_XG = 7552;
constexpr int NMOD = 6 * DM;
constexpr int TOPK = 256;
constexpr int NWAVES = 8, NTHREADS = 512;

constexpr size_t MiB = 1u << 20;
constexpr size_t WS_CTL = 0, CTL_ZERO_BYTES = 1 * MiB;
constexpr size_t WS_MODP = 1 * MiB;
constexpr size_t WS_MODV = 2 * MiB;
constexpr size_t WS_ROPE = 2 * MiB + 128 * 1024;
constexpr size_t WS_IWF = 4 * MiB;
constexpr size_t WS_LORAT = 5 * MiB;
constexpr size_t WS_WOUT = 8 * MiB;
constexpr size_t WS_WGU = 16 * MiB;
constexpr size_t WS_WDOWN = 60 * MiB;
constexpr size_t WS_WIN = 82 * MiB;
constexpr size_t WS_G = WS_WIN, WS_MASK = WS_WIN + 16 * MiB;
constexpr size_t WS_H = 113 * MiB;
constexpr size_t WS_ACAT = WS_H, WS_A = WS_H + 8 * MiB;
constexpr size_t WS_PROJ = 145 * MiB;
constexpr size_t WS_ACT = WS_PROJ;
constexpr size_t WS_RS = 269 * MiB, WS_KS = 285 * MiB, WS_VS = 301 * MiB, WS_KK = 317 * MiB;
constexpr size_t WS_ATT = 333 * MiB;
constexpr size_t WS_END = 365 * MiB;
constexpr size_t OUT_O = 0, OUT_DECAY = 32 * MiB;

constexpr int RING_BYTES = 131072;
constexpr int LDSCTL_OFF = RING_BYTES, MISC_OFF = LDSCTL_OFF + 320;
constexpr int LDS_BYTES = 147456;

#define LAS __attribute__((address_space(3)))
#define GAS __attribute__((address_space(1)))
typedef unsigned short bf16;
typedef unsigned v4u __attribute__((ext_vector_type(4)));
typedef unsigned v2u __attribute__((ext_vector_type(2)));
typedef float v4f __attribute__((ext_vector_type(4)));
typedef float v2f __attribute__((ext_vector_type(2)));
typedef short s8v __attribute__((ext_vector_type(8)));
typedef unsigned long long u64;
typedef GAS unsigned gu32;
#define RLX_AGENT __ATOMIC_RELAXED, __HIP_MEMORY_SCOPE_AGENT
#define LDS_WAIT() asm volatile("s_waitcnt lgkmcnt(0)" ::: "memory")
#define VM_WAIT() asm volatile("s_waitcnt vmcnt(0)" ::: "memory")

__device__ __forceinline__ unsigned f2bf(float f) { unsigned u = __builtin_bit_cast(unsigned, f); return (u + 0x7fffu + ((u >> 16) & 1u)) >> 16; }
__device__ __forceinline__ unsigned pk2(float lo, float hi) { unsigned r; asm volatile("v_cvt_pk_bf16_f32 %0, %1, %2" : "=v"(r) : "v"(lo), "v"(hi)); return r; }
__device__ __forceinline__ float bf_lo(unsigned u) { return __builtin_bit_cast(float, u << 16); }
__device__ __forceinline__ float bf_hi(unsigned u) { return __builtin_bit_cast(float, u & 0xffff0000u); }
__device__ __forceinline__ float bf2f(bf16 u) { return __builtin_bit_cast(float, (unsigned)u << 16); }
__device__ __forceinline__ void load8(const bf16* p, float (&x)[8]) {
    const v4u v = *(const v4u*)p;
    x[0] = bf_lo(v.x); x[1] = bf_hi(v.x); x[2] = bf_lo(v.y); x[3] = bf_hi(v.y); x[4] = bf_lo(v.z); x[5] = bf_hi(v.z); x[6] = bf_lo(v.w); x[7] = bf_hi(v.w);
}
__device__ __forceinline__ void store8(bf16* p, const float (&x)[8]) {
    v4u v; v.x = pk2(x[0], x[1]); v.y = pk2(x[2], x[3]); v.z = pk2(x[4], x[5]); v.w = pk2(x[6], x[7]); *(v4u*)p = v;
}
__device__ __forceinline__ void loadf8(const float* p, float (&x)[8]) {
    const v4f a = *(const v4f*)p, b = *(const v4f*)(p + 4);
    x[0] = a.x; x[1] = a.y; x[2] = a.z; x[3] = a.w; x[4] = b.x; x[5] = b.y; x[6] = b.z; x[7] = b.w;
}
template <int CTRL> __device__ __forceinline__ float dppf(float x) {
    return __builtin_bit_cast(float, __builtin_amdgcn_update_dpp(0, __builtin_bit_cast(int, x), CTRL, 0xf, 0xf, true));
}
__device__ __forceinline__ float sum4(float x) { x += dppf<0xB1>(x); x += dppf<0x4E>(x); return x; }
__device__ __forceinline__ float sum8(float x) { x = sum4(x); x += dppf<0x141>(x); return x; }
__device__ __forceinline__ float sum16(float x) { x = sum8(x); x += dppf<0x140>(x); return x; }
__device__ __forceinline__ float wave_sum(float v) {
#pragma unroll
    for (int o = 1; o < 64; o <<= 1) v += __shfl_xor(v, o);
    return v;
}
__device__ __forceinline__ float fsigmoid(float x) { return 1.f / (1.f + __expf(-x)); }

namespace pg8 {
#define PG8_LAS __attribute__((address_space(3)))
typedef unsigned short bf16_t;
typedef short bf16x8 __attribute__((ext_vector_type(8)));
typedef float f32x4 __attribute__((ext_vector_type(4)));
typedef unsigned u32x4 __attribute__((ext_vector_type(4)));
constexpr int BM = 256, BK = 64, HALF = 128, HTB = HALF * BK * 2  , STAGE_BYTES = 8 * HTB, NXCD = 8, WGM = 8;

__host__ __device__ __forceinline__ int lds_byte(int r, int c) { const int st = (r >> 4) * 2 + (c >> 5), rr = r & 15, cc = c & 31, ob = rr * 64 + cc * 2; return st * 1024 + (ob ^ (((ob >> 9) & 1) << 5)); }
__host__ __device__ __forceinline__ void stage_rc(int b, int& R, int& C) { const int st = b / 1024, sb = b % 1024, swz = sb ^ (((sb >> 9) & 1) << 5); R = (st >> 1) * 16 + swz / 64; C = (st & 1) * 32 + (swz % 64) / 2; }
__host__ __device__ __forceinline__ int perm32(int rho) { const int n = rho >> 4, i = rho & 15; return 8 * (i >> 2) + 4 * n + (i & 3); }

struct Unit { int pm, pn; };
struct Gemm { const bf16_t* A; const bf16_t* Bt; int M, N, K; };

struct StaticOrder {
    int nM, nN, nwg, G, c;
    __host__ __device__ void init(int M, int N, int G_, int c_) { nM = M / BM; nN = N / BM; nwg = nM * nN; G = G_; c = c_; }
    __host__ __device__ bool next(int i, Unit& u) const {
        const long L = (long)i * G + c; if (L >= nwg) return false;
        int wgid = (int)L; { const int q = nwg / NXCD, r = nwg % NXCD, xcd = wgid % NXCD, off = wgid / NXCD; wgid = (xcd < r ? xcd * (q + 1) : r * (q + 1) + (xcd - r) * q) + off; }
        const int nig = WGM * nN, gid = wgid / nig, fm = gid * WGM, gsz = (nM - fm) < WGM ? (nM - fm) : WGM;
        u.pm = fm + ((wgid % nig) % gsz); u.pn = (wgid % nig) / gsz; return true;
    }
    __device__ __forceinline__ void a_ready(const Unit&) const {}
    __device__ __forceinline__ void done(const Unit&) const {}
};


__device__ __forceinline__ unsigned cvt_pk_bf16(float lo, float hi) { unsigned r; asm volatile("v_cvt_pk_bf16_f32 %0, %1, %2" : "=v"(r) : "v"(lo), "v"(hi)); return r; }

struct EpiStore {
    static constexpr bool PERM = true, AFTER_DRAIN = false;
    bf16_t* O; int ldc;
    __device__ __forceinline__ void operator()(const f32x4 (&acc)[2][2][4][2], const Unit& u, int wr, int wc, int fr, int fq) const {
        const int row0 = u.pm * BM + wr * 64 + fr, col0 = u.pn * BM + wc * 32 + 8 * fq;
#pragma unroll
        for (int ai = 0; ai < 2; ++ai)
#pragma unroll
            for (int m = 0; m < 4; ++m) { bf16_t* rowp = O + (size_t)(row0 + ai * HALF + m * 16) * ldc + col0;
#pragma unroll
                for (int bj = 0; bj < 2; ++bj) { const f32x4 v0 = acc[ai][bj][m][0], v1 = acc[ai][bj][m][1];
                    u32x4 w; w.x = cvt_pk_bf16(v0[0], v0[1]); w.y = cvt_pk_bf16(v0[2], v0[3]); w.z = cvt_pk_bf16(v1[0], v1[1]); w.w = cvt_pk_bf16(v1[2], v1[3]);
                    *(u32x4*)(rowp + bj * HALF) = w; } }
    }
};

struct EpiSwiGLU {
    static constexpr bool PERM = true, AFTER_DRAIN = false;
    bf16_t* O; int ldc;
    __device__ __forceinline__ void operator()(const f32x4 (&acc)[2][2][4][2], const Unit& u, int wr, int wc, int fr, int fq) const {
        const int row0 = u.pm * BM + wr * 64 + fr, col0 = u.pn * HALF + wc * 32 + 8 * fq;
#pragma unroll
        for (int ai = 0; ai < 2; ++ai)
#pragma unroll
            for (int m = 0; m < 4; ++m) { bf16_t* rowp = O + (size_t)(row0 + ai * HALF + m * 16) * ldc + col0;
                float r[8];
#pragma unroll
                for (int n = 0; n < 2; ++n)
#pragma unroll
                    for (int j = 0; j < 4; ++j) { const float g = acc[ai][0][m][n][j], up = acc[ai][1][m][n][j]; r[n * 4 + j] = g * up / (1.f + __expf(-g)); }
                u32x4 w; w.x = cvt_pk_bf16(r[0], r[1]); w.y = cvt_pk_bf16(r[2], r[3]); w.z = cvt_pk_bf16(r[4], r[5]); w.w = cvt_pk_bf16(r[6], r[7]);
                *(u32x4*)rowp = w; }
    }
};

struct EpiRes {
    static constexpr bool PERM = true, AFTER_DRAIN = false;
    const float* res; float* out; const float* gt;
    int gt_stride;
    __device__ __forceinline__ void operator()(const f32x4 (&acc)[2][2][4][2], const Unit& u, int wr, int wc, int fr, int fq) const {
        const int row0 = u.pm * BM + wr * 64 + fr, col0 = u.pn * BM + wc * 32 + 8 * fq;
        const float* gtb = gt + (size_t)((u.pm * BM) >= 4096 ? 1 : 0) * gt_stride + col0;
        f32x4 gv[2][2];
#pragma unroll
        for (int bj = 0; bj < 2; ++bj)
#pragma unroll
            for (int n = 0; n < 2; ++n) gv[bj][n] = *(const f32x4*)(gtb + bj * HALF + 4 * n);
#pragma unroll
        for (int ai = 0; ai < 2; ++ai)
#pragma unroll
            for (int m = 0; m < 4; ++m) { const size_t off = (size_t)(row0 + ai * HALF + m * 16) * 2048 + col0;
#pragma unroll
                for (int bj = 0; bj < 2; ++bj)
#pragma unroll
                    for (int n = 0; n < 2; ++n) { const f32x4 x = *(const f32x4*)(res + off + bj * HALF + 4 * n);
                        *(f32x4*)(out + off + bj * HALF + 4 * n) = x + gv[bj][n] * acc[ai][bj][m][n]; } }
    }
};

struct EpiLora {
    static constexpr bool PERM = true, AFTER_DRAIN = false;
    float* decay; bf16_t* abuf; bf16_t* gbuf; const float* w0; const float* a0;
    template <int WHICH>
    __device__ __forceinline__ void run(const f32x4 (&acc)[2][2][4][2], int row0, int col0) const {
#pragma unroll
        for (int bj = 0; bj < 2; ++bj) {
            const int c = col0 + bj * HALF;
            float bias[8];
#pragma unroll
            for (int j = 0; j < 8; ++j) bias[j] = WHICH == 0 ? w0[c + j] : (WHICH == 1 ? a0[c + j] : 0.f);
#pragma unroll
            for (int ai = 0; ai < 2; ++ai)
#pragma unroll
                for (int m = 0; m < 4; ++m) { const size_t off = (size_t)(row0 + ai * HALF + m * 16) * 1024 + c;
                    float r[8];
#pragma unroll
                    for (int n = 0; n < 2; ++n)
#pragma unroll
                        for (int j = 0; j < 4; ++j) r[n * 4 + j] = acc[ai][bj][m][n][j] + bias[n * 4 + j];
                    if (WHICH == 0) {
#pragma unroll
                        for (int j = 0; j < 8; ++j) r[j] = __expf(-0.6065306597126334f / (1.f + __expf(-r[j])));
                        *(f32x4*)(decay + off) = (f32x4){r[0], r[1], r[2], r[3]}; *(f32x4*)(decay + off + 4) = (f32x4){r[4], r[5], r[6], r[7]};
                    } else {
                        if (WHICH == 1) {
#pragma unroll
                            for (int j = 0; j < 8; ++j) r[j] = 1.f / (1.f + __expf(-r[j]));
                        }
                        u32x4 w; w.x = cvt_pk_bf16(r[0], r[1]); w.y = cvt_pk_bf16(r[2], r[3]); w.z = cvt_pk_bf16(r[4], r[5]); w.w = cvt_pk_bf16(r[6], r[7]);
                        *(u32x4*)((WHICH == 1 ? abuf : gbuf) + off) = w;
                    } }
        }
    }
    __device__ __forceinline__ void operator()(const f32x4 (&acc)[2][2][4][2], const Unit& u, int wr, int wc, int fr, int fq) const {
        const int which = u.pn >> 2;
        const int row0 = u.pm * BM + wr * 64 + fr, col0 = (u.pn & 3) * BM + wc * 32 + 8 * fq;
        if (which == 0) run<0>(acc, row0, col0); else if (which == 1) run<1>(acc, row0, col0); else run<2>(acc, row0, col0);
    }
};

template <class Epi, class Sched, bool ALIGN_EPI = false, bool SP2 = false>
__device__ __forceinline__ void gemm_phase(PG8_LAS unsigned char* lds, const Gemm g, const Sched& S, const Epi& E) {
    const int tid = threadIdx.x, wid = __builtin_amdgcn_readfirstlane(tid >> 6), lane = tid & 63, wr = wid >> 2, wc = wid & 3, fr = lane & 15, fq = lane >> 4;
    const int K = g.K, nt = K / BK;
    unsigned voffA[2], voffB[2];
#pragma unroll
    for (int i = 0; i < 2; ++i) { int R, C; stage_rc(tid * 16 + i * 8192, R, C); const int Rb = Epi::PERM ? ((R & ~31) + perm32(R & 31)) : R;
        voffA[i] = (unsigned)(R * K + C) * 2u; voffB[i] = (unsigned)(Rb * K + C) * 2u; }
    const size_t kstep = (size_t)(BK * 2);
    const size_t hstep = (size_t)HALF * K * 2;
    const size_t tstep = 2 * hstep;
    const unsigned ldsw = (unsigned)wid * 1024u;
    const int aoff = lds_byte(wr * 64 + fr, fq * 8), boff = lds_byte(wc * 32 + fr, fq * 8);
#define PG8_SA(b, h) (((b) * 2 + (h)) * HTB)
#define PG8_SB(b, h) ((4 + (b) * 2 + (h)) * HTB)
#define PG8_STAGE(bufoff, gbase, voff) do { _Pragma("unroll") for (int _i = 0; _i < 2; ++_i) \
        __builtin_amdgcn_global_load_lds((const unsigned*)((const char*)(gbase) + (voff)[_i]), (PG8_LAS unsigned*)(lds + (bufoff) + ldsw + _i * 8192), 16, 0, 0); } while (0)
#define PG8_LDA(dst, b, h) do { _Pragma("unroll") for (int m = 0; m < 4; ++m) _Pragma("unroll") for (int k = 0; k < 2; ++k) dst[m][k] = *(const PG8_LAS bf16x8*)(lds + PG8_SA(b, h) + aoff + m * 2048 + k * 1024); } while (0)
#define PG8_LDB(dst, b, h) do { _Pragma("unroll") for (int n = 0; n < 2; ++n) _Pragma("unroll") for (int k = 0; k < 2; ++k) dst[n][k] = *(const PG8_LAS bf16x8*)(lds + PG8_SB(b, h) + boff + n * 2048 + k * 1024); } while (0)
#define PG8_MMA(ai, bj, At, Bt) do { __builtin_amdgcn_s_setprio(1); _Pragma("unroll") for (int m = 0; m < 4; ++m) _Pragma("unroll") for (int n = 0; n < 2; ++n) _Pragma("unroll") for (int k = 0; k < 2; ++k) \
        acc[ai][bj][m][n] = __builtin_amdgcn_mfma_f32_16x16x32_bf16(Bt[n][k], At[m][k], acc[ai][bj][m][n], 0, 0, 0); __builtin_amdgcn_s_setprio(0); } while (0)
#define PG8_WAIT_V(n) asm volatile("s_waitcnt vmcnt(" #n ")" ::: "memory")
#define PG8_WAIT_L(n) asm volatile("s_waitcnt lgkmcnt(" #n ")" ::: "memory")
#define PG8_BAR __builtin_amdgcn_s_barrier()
#define PG8_SCHED __builtin_amdgcn_sched_barrier(0)
    Unit cur, nxt; int ui = 0;
    if (!S.next(0, cur)) return;
    f32x4 acc[2][2][4][2];
#pragma unroll
    for (int a = 0; a < 2; ++a)
#pragma unroll
        for (int b = 0; b < 2; ++b)
#pragma unroll
            for (int m = 0; m < 4; ++m)
#pragma unroll
                for (int n = 0; n < 2; ++n) acc[a][b][m][n] = (f32x4){0.f, 0.f, 0.f, 0.f};
    bf16x8 At[4][2], B0[2][2], B1[2][2];
    const char* cA = (const char*)g.A + (size_t)cur.pm * tstep; const char* cB = (const char*)g.Bt + (size_t)cur.pn * tstep;
    S.a_ready(cur);
    if constexpr (SP2) {
        PG8_STAGE(PG8_SB(0, 0), cB, voffB); PG8_STAGE(PG8_SB(0, 1), cB + hstep, voffB); PG8_STAGE(PG8_SA(0, 0), cA, voffA); PG8_STAGE(PG8_SA(0, 1), cA + hstep, voffA);
        if (wr == 1) PG8_BAR;
        PG8_WAIT_V(2); PG8_BAR;
        PG8_STAGE(PG8_SB(1, 0), cB + kstep, voffB); PG8_STAGE(PG8_SA(1, 0), cA + kstep, voffA); PG8_STAGE(PG8_SB(1, 1), cB + hstep + kstep, voffB);
        PG8_WAIT_V(6); PG8_BAR;
    } else {
        PG8_STAGE(PG8_SB(0, 0), cB, voffB); PG8_STAGE(PG8_SA(0, 0), cA, voffA); PG8_STAGE(PG8_SB(0, 1), cB + hstep, voffB); PG8_STAGE(PG8_SA(0, 1), cA + hstep, voffA);
        if (wr == 1) PG8_BAR;
        PG8_WAIT_V(4); PG8_BAR;
        PG8_STAGE(PG8_SB(1, 0), cB + kstep, voffB); PG8_STAGE(PG8_SA(1, 0), cA + kstep, voffA); PG8_STAGE(PG8_SB(1, 1), cB + hstep + kstep, voffB);
        PG8_WAIT_V(6); PG8_BAR;
    }
    for (;;) {
        const bool has_next = S.next(ui + 1, nxt);
        const char* nA = has_next ? (const char*)g.A + (size_t)nxt.pm * tstep : cA; const char* nB = has_next ? (const char*)g.Bt + (size_t)nxt.pn * tstep : cB;
        for (int t = 0; t < nt; t += 2) {
            const bool last = (t == nt - 2);
            const char* a1 = cA + (size_t)(t + 1) * kstep;
            const char* a2 = last ? nA : cA + (size_t)(t + 2) * kstep; const char* b2 = last ? nB : cB + (size_t)(t + 2) * kstep;
            const char* a3 = a2 + kstep; const char* b3 = b2 + kstep;
            if (last && has_next) S.a_ready(nxt);
            if constexpr (SP2) {
            PG8_LDB(B0, 0, 0); PG8_LDB(B1, 0, 1); PG8_SCHED; PG8_LDA(At, 0, 0); PG8_STAGE(PG8_SA(1, 1), a1 + hstep, voffA);
            PG8_WAIT_V(8); PG8_WAIT_L(0); PG8_BAR; PG8_MMA(0, 0, At, B0); PG8_MMA(0, 1, At, B1); PG8_BAR; PG8_SCHED;
            PG8_LDA(At, 0, 1); PG8_STAGE(PG8_SB(0, 0), b2, voffB); PG8_STAGE(PG8_SB(0, 1), b2 + hstep, voffB); PG8_STAGE(PG8_SA(0, 0), a2, voffA);
            PG8_WAIT_V(8); PG8_WAIT_L(0); PG8_BAR; PG8_MMA(1, 0, At, B0); PG8_MMA(1, 1, At, B1); PG8_BAR; PG8_SCHED;
            PG8_LDB(B0, 1, 0); PG8_LDB(B1, 1, 1); PG8_SCHED; PG8_LDA(At, 1, 0); PG8_STAGE(PG8_SA(0, 1), a2 + hstep, voffA);
            PG8_WAIT_V(8); PG8_WAIT_L(0); PG8_BAR; PG8_MMA(0, 0, At, B0); PG8_MMA(0, 1, At, B1); PG8_BAR; PG8_SCHED;
            PG8_LDA(At, 1, 1); PG8_STAGE(PG8_SB(1, 0), b3, voffB); PG8_STAGE(PG8_SB(1, 1), b3 + hstep, voffB); PG8_STAGE(PG8_SA(1, 0), a3, voffA);
            PG8_WAIT_V(8); PG8_WAIT_L(0); PG8_BAR; PG8_MMA(1, 0, At, B0); PG8_MMA(1, 1, At, B1); PG8_BAR; PG8_SCHED;
            } else {
            PG8_LDB(B0, 0, 0); PG8_SCHED; PG8_LDA(At, 0, 0); PG8_STAGE(PG8_SA(1, 1), a1 + hstep, voffA);
            PG8_WAIT_L(8); PG8_BAR; PG8_WAIT_L(0); PG8_MMA(0, 0, At, B0); PG8_BAR; PG8_SCHED;
            PG8_LDB(B1, 0, 1); PG8_STAGE(PG8_SB(0, 0), b2, voffB);
            PG8_BAR; PG8_WAIT_L(0); PG8_MMA(0, 1, At, B1); PG8_BAR;
            PG8_LDA(At, 0, 1); PG8_STAGE(PG8_SA(0, 0), a2, voffA);
            PG8_BAR; PG8_WAIT_L(0); PG8_MMA(1, 0, At, B0); PG8_BAR; PG8_SCHED;
            PG8_STAGE(PG8_SB(0, 1), b2 + hstep, voffB);
            PG8_WAIT_V(6); PG8_BAR; PG8_MMA(1, 1, At, B1); PG8_BAR;
            PG8_LDB(B0, 1, 0); PG8_SCHED; PG8_LDA(At, 1, 0); PG8_STAGE(PG8_SA(0, 1), a2 + hstep, voffA);
            PG8_WAIT_L(8); PG8_BAR; PG8_WAIT_L(0); PG8_MMA(0, 0, At, B0); PG8_BAR; PG8_SCHED;
            PG8_LDB(B1, 1, 1); PG8_STAGE(PG8_SB(1, 0), b3, voffB);
            PG8_BAR; PG8_WAIT_L(0); PG8_MMA(0, 1, At, B1); PG8_BAR;
            PG8_LDA(At, 1, 1); PG8_STAGE(PG8_SA(1, 0), a3, voffA);
            PG8_BAR; PG8_WAIT_L(0); PG8_MMA(1, 0, At, B0); PG8_BAR; PG8_SCHED;
            PG8_STAGE(PG8_SB(1, 1), b3 + hstep, voffB);
            PG8_WAIT_V(6); PG8_BAR; PG8_MMA(1, 1, At, B1); PG8_BAR;
            }
        }
        if constexpr (ALIGN_EPI) { if (wr == 0) PG8_BAR; }
        if constexpr (!Epi::AFTER_DRAIN) { E(acc, cur, wr, wc, fr, fq); S.done(cur); }
        if (!has_next) break;
#pragma unroll
        for (int a = 0; a < 2; ++a)
#pragma unroll
            for (int b = 0; b < 2; ++b)
#pragma unroll
                for (int m = 0; m < 4; ++m)
#pragma unroll
                    for (int n = 0; n < 2; ++n) acc[a][b][m][n] = (f32x4){0.f, 0.f, 0.f, 0.f};
        cur = nxt; cA = nA; cB = nB; ++ui;
        if constexpr (ALIGN_EPI) { if (wr == 1) PG8_BAR; }
    }
    PG8_WAIT_V(0);
    if constexpr (!ALIGN_EPI) { if (wr == 0) PG8_BAR; }
    PG8_BAR;
    if constexpr (Epi::AFTER_DRAIN) { E.fused(acc, cur, wr, wc, fr, fq, lds, wid, lane); S.done(cur); }
#undef PG8_SA
#undef PG8_SB
#undef PG8_STAGE
#undef PG8_LDA
#undef PG8_LDB
#undef PG8_MMA
#undef PG8_WAIT_V
#undef PG8_WAIT_L
#undef PG8_BAR
#undef PG8_SCHED
}
}

#define XB_TMO      128
#define XB_XCNT(j)  (256  + 64 * (j))
#define XB_XSUB(j)  (1280 + 64 * (j))
#define XB_XGEN(j)  (2304 + 64 * (j))
#define XB_TOP      3328
#define XB_TOPGEN   3392
#define XCD_BAR_WORDS 3456
#define XB_SPIN_CAP (1u << 18)

__device__ __forceinline__ unsigned xb_ld(unsigned* p)              { return __hip_atomic_load(p, __ATOMIC_RELAXED, __HIP_MEMORY_SCOPE_AGENT); }
__device__ __forceinline__ unsigned xb_add(unsigned* p, unsigned v) { return __hip_atomic_fetch_add(p, v, __ATOMIC_RELAXED, __HIP_MEMORY_SCOPE_AGENT); }
__device__ __forceinline__ unsigned xb_xcc_id() { return (unsigned)__builtin_amdgcn_s_getreg((3 << 11) | 20) & 0xFu; }
#define XB_SPIN(cond, bar) do { unsigned _sp = 0; while (cond) { __builtin_amdgcn_s_sleep(1); \
    if ((++_sp & 255u) == 0u) { if (xb_ld(&(bar)[XB_TMO])) break; if (_sp > XB_SPIN_CAP) { atomicAdd(&(bar)[XB_TMO], 1u); break; } } } } while (0)

struct XcdBarrier {
    unsigned* bar; unsigned x;
    volatile LAS unsigned* st;
};

__device__ __forceinline__ XcdBarrier xcd_barrier_post(unsigned* bar, volatile LAS unsigned* st) {
    XcdBarrier b; b.bar = bar; b.x = xb_xcc_id(); b.st = st;
    if (threadIdx.x == 0) (void)xb_add(&bar[XB_XCNT(b.x)], 1u);
    return b;
}
__device__ __forceinline__ void xcd_barrier_complete(unsigned* bar, unsigned x, unsigned& nloc, unsigned& nx) {
    const unsigned G = gridDim.x * gridDim.y * gridDim.z;
    unsigned sum, cnt, mine, sp = 0u;
    for (;;) {
        sum = 0u; cnt = 0u; mine = 0u;
#pragma unroll
        for (unsigned j = 0; j < 16; ++j) { const unsigned c = xb_ld(&bar[XB_XCNT(j)]); sum += c; cnt += (c > 0u) ? 1u : 0u; mine = (j == x) ? c : mine; }
        if (sum == G) break;
        __builtin_amdgcn_s_sleep(1);
        if ((++sp & 255u) == 0u) { if (xb_ld(&bar[XB_TMO])) break; if (sp > XB_SPIN_CAP) { atomicAdd(&bar[XB_TMO], 1u); break; } }
    }
    nloc = mine > 0u ? mine : 1u; nx = cnt > 0u ? cnt : 1u;
}

__device__ __forceinline__ void xcd_barrier(const XcdBarrier& b) {
    asm volatile("s_waitcnt vmcnt(0)" ::: "memory");
    __syncthreads();
    if (threadIdx.x == 0) {
        unsigned* bar = b.bar;
        __builtin_amdgcn_s_waitcnt(0);
        unsigned nloc = b.st[0], nx = b.st[1];
        if (nloc == 0u) { xcd_barrier_complete(bar, b.x, nloc, nx); b.st[0] = nloc; b.st[1] = nx; }
        const unsigned old = xb_add(&bar[XB_XSUB(b.x)], 1u);
        const unsigned gen = old / nloc;
        if (old + 1u == (gen + 1u) * nloc) {
            __builtin_amdgcn_fence(__ATOMIC_RELEASE, "agent");
            asm volatile("s_waitcnt vmcnt(0)" ::: "memory");
            const unsigned og = xb_add(&bar[XB_TOP], 1u);
            const unsigned tg = og / nx;
            if (og + 1u == (tg + 1u) * nx) xb_add(&bar[XB_TOPGEN], 1u);
            else XB_SPIN(xb_ld(&bar[XB_TOPGEN]) == tg, bar);
            __builtin_amdgcn_fence(__ATOMIC_ACQUIRE, "agent");
            xb_add(&bar[XB_XGEN(b.x)], 1u);
            asm volatile("s_waitcnt vmcnt(0)" ::: "memory");
        } else {
            XB_SPIN(xb_ld(&bar[XB_XGEN(b.x)]) == gen, bar);
            __builtin_amdgcn_fence(__ATOMIC_ACQUIRE, "agent");
            asm volatile("s_waitcnt vmcnt(0)" ::: "memory");
        }
    }
    __syncthreads();
}

struct Params { const float* in[25]; float* out; unsigned char* ws; int ph_lo, ph_hi; };
static_assert(sizeof(Params) == 27 * 8 + 8, "Params has no padding");
struct Frame {
    LAS unsigned char* lds;
    int tid, lane, wave, bid, G;
    float* out;
    unsigned char* ws;
};
#define IN_X 0
#define IN_C 1
#define IN_POS 2
#define IN_WADA 3
#define IN_BADA 4
#define IN_N1G 5
#define IN_WIN 6
#define IN_QG 7
#define IN_KG 8
#define IN_MU 9
#define IN_W0 10
#define IN_WUP 11
#define IN_A0 12
#define IN_AUP 13
#define IN_GUP 14
#define IN_KK 15
#define IN_KA 16
#define IN_RK 17
#define IN_LNG 18
#define IN_LNB 19
#define IN_WOUT 20
#define IN_N2G 21
#define IN_WG 22
#define IN_WU 23
#define IN_WD 24

template <class RowMap>
__device__ __forceinline__ void transpose_item(const float* W, int ldw, int Ksrc, int Nsrc, int k0, int n0, bf16* WT, int ldt, int dk0, const RowMap& rm, LAS float* scr, int lane) {
    const int nn = n0 + (lane & 31);
#pragma unroll 8
    for (int i = 0; i < 32; ++i) { const int kk = 2 * i + (lane >> 5), k = k0 + kk;
        scr[kk * 33 + (lane & 31)] = (k < Ksrc && nn < Nsrc) ? W[(size_t)k * ldw + nn] : 0.f; }
    LDS_WAIT(); asm volatile("" ::: "memory");
    const int c = lane & 7;
#pragma unroll
    for (int j = 0; j < 4; ++j) { const int nl = (lane >> 3) + 8 * j, n = n0 + nl; const LAS float* s = scr + (8 * c) * 33 + nl;
        v4u o; o.x = pk2(s[0 * 33], s[1 * 33]); o.y = pk2(s[2 * 33], s[3 * 33]); o.z = pk2(s[4 * 33], s[5 * 33]); o.w = pk2(s[6 * 33], s[7 * 33]);
        if (n < Nsrc) *(v4u*)(WT + (size_t)rm(n) * ldt + dk0 + k0 + 8 * c) = o; }
    LDS_WAIT(); asm volatile("" ::: "memory");
}
struct RmIdent { int off; __device__ __forceinline__ int operator()(int n) const { return off + n; } };
struct RmGU { int half; __device__ __forceinline__ int operator()(int n) const { return 256 * (n >> 7) + half + (n & 127); } };
struct RmWin { __device__ __forceinline__ int operator()(int n) const {
    if (n < 4096) return n;
    if (n < 4160) return P_IK + (n - 4096);
    if (n < 4176) return P_IW + (n - 4160);
    if (n < 7248) return P_R + (n - 4176);
    if (n < 7344) return P_XW + (n - 7248);
    if (n < 7440) return P_XA + (n - 7344);
    return P_XG + (n - 7440); } };

__device__ __forceinline__ void phase_p0(Frame& F, const Params& P) {
    const int gw = F.bid * NWAVES + F.wave, NGW = F.G * NWAVES;
    {
        const int cb = F.bid & 31, ks = F.bid >> 5;
        if (ks < 8) {
            const float* wada = P.in[IN_WADA]; const float* cc = P.in[IN_C];
            const int kb = ks * 256 + F.wave * 32;
            v2f acc[2][3];
#pragma unroll
            for (int b = 0; b < 2; ++b)
#pragma unroll
                for (int p = 0; p < 3; ++p) acc[b][p] = (v2f){0.f, 0.f};
#pragma unroll 4
            for (int r = 0; r < 32; ++r) {
                const int k = kb + r;
                const float c0 = cc[k], c1 = cc[DM + k];
                const float s0 = c0 / (1.f + __expf(-c0)), s1 = c1 / (1.f + __expf(-c1));
                const float* wr = wada + (size_t)k * NMOD + cb * 384 + 2 * F.lane;
#pragma unroll
                for (int p = 0; p < 3; ++p) { const v2f w = *(const v2f*)(wr + p * 128); acc[0][p] += w * s0; acc[1][p] += w * s1; }
            }
            LAS v2f* red = (LAS v2f*)F.lds;
#pragma unroll
            for (int b = 0; b < 2; ++b)
#pragma unroll
                for (int p = 0; p < 3; ++p) red[((F.wave * 2 + b) * 3 + p) * 64 + F.lane] = acc[b][p];
            __syncthreads();
            if (F.tid < 384) {
                const int b = F.tid / 192, p = (F.tid % 192) / 64, l = F.tid & 63;
                v2f s = (v2f){0.f, 0.f};
#pragma unroll
                for (int w = 0; w < 8; ++w) s += red[((w * 2 + b) * 3 + p) * 64 + l];
                float* modp = (float*)(F.ws + WS_MODP);
                *(v2f*)(modp + ((size_t)ks * 2 + b) * NMOD + cb * 384 + p * 128 + 2 * l) = s;
            }
            __syncthreads();
        }
    }
    LAS float* scr = (LAS float*)(F.lds + F.wave * 16384);
    bf16* win_t = (bf16*)(F.ws + WS_WIN); bf16* wout_t = (bf16*)(F.ws + WS_WOUT); bf16* wgu_t = (bf16*)(F.ws + WS_WGU); bf16* wdown_t = (bf16*)(F.ws + WS_WDOWN); bf16* lora_t = (bf16*)(F.ws + WS_LORAT);
    constexpr int NB_IN = (IN_COLS + 31) / 32;
    constexpr int I_IN = 32 * NB_IN, I_OUT = 32 * 64, I_G = 32 * 176, I_D = 88 * 64, I_WUP = 2 * 32, I_GUP = 4 * 32;
    constexpr int NITEMS = I_IN + I_OUT + 2 * I_G + I_D + 2 * I_WUP + I_GUP;
    for (int it = gw; it < NITEMS; it += NGW) {
        int r = it;
        if (r < I_IN) { transpose_item(P.in[IN_WIN], IN_COLS, DM, IN_COLS, 64 * (r / NB_IN), 32 * (r % NB_IN), win_t, DM, 0, RmWin{}, scr, F.lane); continue; } r -= I_IN;
        if (r < I_OUT) { transpose_item(P.in[IN_WOUT], DM, DM, DM, 64 * (r / 64), 32 * (r % 64), wout_t, DM, 0, RmIdent{0}, scr, F.lane); continue; } r -= I_OUT;
        if (r < I_G) { transpose_item(P.in[IN_WG], DFF, DM, DFF, 64 * (r / 176), 32 * (r % 176), wgu_t, DM, 0, RmGU{0}, scr, F.lane); continue; } r -= I_G;
        if (r < I_G) { transpose_item(P.in[IN_WU], DFF, DM, DFF, 64 * (r / 176), 32 * (r % 176), wgu_t, DM, 0, RmGU{128}, scr, F.lane); continue; } r -= I_G;
        if (r < I_D) { transpose_item(P.in[IN_WD], DM, DFF, DM, 64 * (r / 64), 32 * (r % 64), wdown_t, DFF, 0, RmIdent{0}, scr, F.lane); continue; } r -= I_D;
        if (r < I_WUP) { transpose_item(P.in[IN_WUP], 1024, 96, 1024, 64 * (r / 32), 32 * (r % 32), lora_t, 512, 0, RmIdent{0}, scr, F.lane); continue; } r -= I_WUP;
        if (r < I_WUP) { transpose_item(P.in[IN_AUP], 1024, 96, 1024, 64 * (r / 32), 32 * (r % 32), lora_t, 512, 128, RmIdent{1024}, scr, F.lane); continue; } r -= I_WUP;
        transpose_item(P.in[IN_GUP], 1024, 256, 1024, 64 * (r / 32), 32 * (r % 32), lora_t, 512, 256, RmIdent{2048}, scr, F.lane);
    }
    {
        const int gt = F.bid * NTHREADS + F.tid, NGT = F.G * NTHREADS;
        const v4u z = (v4u){0u, 0u, 0u, 0u};
        for (int i = gt; i < 240 * 256; i += NGT) { int rr = i >> 8; const int ch = i & 255;
            const int row = rr < 48 ? 7248 + rr : (rr < 80 ? 7392 + (rr - 48) : (rr < 112 ? 7520 + (rr - 80) : 7808 + (rr - 112)));
            *(v4u*)(win_t + (size_t)row * DM + ch * 8) = z; }
        for (int i = gt; i < 3072 * 64; i += NGT) { const int row = i >> 6, ch = i & 63; const int rb = row >> 10;
            const bool live = rb == 0 ? (ch < 16) : (rb == 1 ? (ch >= 16 && ch < 32) : (ch >= 32));
            if (!live) *(v4u*)(lora_t + (size_t)row * 512 + ch * 8) = z; }
    }
}

template <bool FROM_PART>
__device__ __forceinline__ void build_mod_vecs(Frame& F, const Params& P, const float* gain, int shift_off, int scale_off) {
    LAS float* vecA = (LAS float*)F.lds; LAS float* vecB = vecA + 2 * DM;
    const float* modp = (const float*)(F.ws + WS_MODP); const float* modv = (const float*)(F.ws + WS_MODV); const float* bada = P.in[IN_BADA];
    for (int i = F.tid; i < 2 * DM; i += NTHREADS) { const int b = i / DM, d = i % DM;
        float sh, sc;
        if (FROM_PART) { sh = bada[shift_off + d]; sc = bada[scale_off + d];
#pragma unroll
            for (int ks = 0; ks < 8; ++ks) { sh += modp[((size_t)ks * 2 + b) * NMOD + shift_off + d]; sc += modp[((size_t)ks * 2 + b) * NMOD + scale_off + d]; } }
        else { sh = modv[(size_t)b * NMOD + shift_off + d]; sc = modv[(size_t)b * NMOD + scale_off + d]; }
        vecA[i] = gain[d] * (1.f + sc); vecB[i] = sh; }
    __syncthreads();
}
__device__ __forceinline__ void norm_rows(Frame& F, const Params& P, const float* src, bf16* dst) {
    const LAS float* vecA = (const LAS float*)F.lds; const LAS float* vecB = vecA + 2 * DM;
    const int gw = F.bid * NWAVES + F.wave, NGW = F.G * NWAVES;
    for (int m = gw; m < T; m += NGW) {
        const int b = m >= SEQ ? 1 : 0;
        const v4f* xr = (const v4f*)(src + (size_t)m * DM) + F.lane;
        v4f v[8]; float s = 0.f;
#pragma unroll
        for (int j = 0; j < 8; ++j) { v[j] = xr[64 * j]; s += (v[j].x * v[j].x + v[j].y * v[j].y) + (v[j].z * v[j].z + v[j].w * v[j].w); }
        const float rs = 1.f / sqrtf(wave_sum(s) * (1.f / DM) + 1e-6f);
        v2u* o8 = (v2u*)(dst + (size_t)m * DM) + F.lane;
#pragma unroll
        for (int j = 0; j < 8; ++j) { const int d = 256 * j + 4 * F.lane;
            const v4f a = *(const LAS v4f*)(vecA + b * DM + d), bb = *(const LAS v4f*)(vecB + b * DM + d);
            const v4f h = v[j] * rs * a + bb;
            v2u w; w.x = pk2(h.x, h.y); w.y = pk2(h.z, h.w); o8[64 * j] = w; }
    }
}
__device__ __forceinline__ void phase_p1(Frame& F, const Params& P) {
    const int gt = F.bid * NTHREADS + F.tid, NGT = F.G * NTHREADS;
    { const float* modp = (const float*)(F.ws + WS_MODP); float* modv = (float*)(F.ws + WS_MODV); const float* bada = P.in[IN_BADA];
      for (int i = gt; i < 2 * NMOD; i += NGT) { const int b = i / NMOD, j = i % NMOD; float s = bada[j];
#pragma unroll
          for (int ks = 0; ks < 8; ++ks) s += modp[((size_t)ks * 2 + b) * NMOD + j];
          modv[i] = s; } }
    { v2f* rope = (v2f*)(F.ws + WS_ROPE); const int* pos = (const int*)P.in[IN_POS];
      for (int i = gt; i < T * 24; i += NGT) { const int m = i / 24, e = i % 24;
          const float ex = e < 16 ? (float)e * (1.f / 16.f) : (float)(e - 16) * (1.f / 8.f);
          const float inv = exp2f(-ex * 18.931568569324174f);
          const float ang = (float)pos[m] * inv;
          const double rev = (double)ang * 0.15915494309189535; const float fr = (float)(rev - __builtin_rint(rev));
          rope[i] = (v2f){__builtin_amdgcn_cosf(fr), __builtin_amdgcn_sinf(fr)}; } }
    build_mod_vecs<true>(F, P, P.in[IN_N1G], 0, DM);
    norm_rows(F, P, P.in[IN_X], (bf16*)(F.ws + WS_H));
}
__device__ __forceinline__ void phase_p6(Frame& F, const Params& P) {
    build_mod_vecs<false>(F, P, P.in[IN_N2G], 3 * DM, 4 * DM);
    norm_rows(F, P, F.out, (bf16*)(F.ws + WS_H));
}

__device__ __forceinline__ void phase_p3a(Frame& F, const Params& P) {
    const int gw = F.bid * NWAVES + F.wave, NGW = F.G * NWAVES, lane = F.lane;
    bf16* proj = (bf16*)(F.ws + WS_PROJ);
    const v2f* rope = (const v2f*)(F.ws + WS_ROPE);
    float* iwf = (float*)(F.ws + WS_IWF);
    bf16* rs_ = (bf16*)(F.ws + WS_RS); bf16* ks_ = (bf16*)(F.ws + WS_KS); bf16* vs_ = (bf16*)(F.ws + WS_VS); bf16* kkb = (bf16*)(F.ws + WS_KK); bf16* acat = (bf16*)(F.ws + WS_ACAT);
    const float* mu = P.in[IN_MU]; const float* k_k = P.in[IN_KK];
    for (int m = gw; m < T; m += NGW) {
        const int t = m & (SEQ - 1);
        bf16* prow = proj + (size_t)m * NP;
        const v2f* rp = rope + (size_t)m * 24;
#pragma unroll
        for (int qk = 0; qk < 2; ++qk) {
            const float* gain = P.in[qk ? IN_KG : IN_QG];
#pragma unroll
            for (int pass = 0; pass < 2; ++pass) {
                const int head = pass * 4 + (lane >> 4), c = lane & 15;
                bf16* p = prow + (qk ? P_K : P_Q) + head * 128 + c * 8;
                float x[8]; load8(p, x);
                float ss = 0.f;
#pragma unroll
                for (int i = 0; i < 8; ++i) ss += x[i] * x[i];
                ss = sum16(ss);
                const float rs = 1.f / sqrtf(ss * (1.f / 128.f) + 1e-6f);
                float g8[8]; loadf8(gain + c * 8, g8);
                float y[8], pr[8];
#pragma unroll
                for (int i = 0; i < 8; ++i) y[i] = x[i] * rs * g8[i];
#pragma unroll
                for (int i = 0; i < 8; ++i) pr[i] = __shfl_xor(y[i], 2);
                if (c < 4) {
#pragma unroll
                    for (int i = 0; i < 8; ++i) { const v2f cs = rp[(c & 1) * 8 + i]; y[i] = c < 2 ? y[i] * cs.x - pr[i] * cs.y : y[i] * cs.x + pr[i] * cs.y; }
                }
                store8(p, y);
            }
        }
#pragma unroll
        for (int pass = 0; pass < 2; ++pass) {
            const int head = pass * 8 + (lane >> 3), c = lane & 7;
            bf16* p = prow + P_IQ + head * 64 + c * 8;
            float x[8], pr[8]; load8(p, x);
#pragma unroll
            for (int i = 0; i < 8; ++i) pr[i] = __shfl_xor(x[i], 1);
            if (c < 2) {
#pragma unroll
                for (int i = 0; i < 8; ++i) { const v2f cs = rp[16 + i]; x[i] = c == 0 ? x[i] * cs.x - pr[i] * cs.y : x[i] * cs.x + pr[i] * cs.y; }
            }
#pragma unroll
            for (int i = 0; i < 8; ++i) x[i] *= 0.125f;
            store8(p, x);
        }
        {
            const int c = lane & 7;
            bf16* p = prow + P_IK + c * 8;
            float x[8], pr[8]; load8(p, x);
#pragma unroll
            for (int i = 0; i < 8; ++i) pr[i] = __shfl_xor(x[i], 1);
            if (c < 2) {
#pragma unroll
                for (int i = 0; i < 8; ++i) { const v2f cs = rp[16 + i]; x[i] = c == 0 ? x[i] * cs.x - pr[i] * cs.y : x[i] * cs.x + pr[i] * cs.y; }
            }
            if (lane < 8) store8(p, x);
        }
        if (lane < 16) iwf[(size_t)m * 16 + lane] = bf2f(prow[P_IW + lane]) * 0.25f;
#pragma unroll
        for (int seg = 0; seg < 3; ++seg)
#pragma unroll
            for (int pass = 0; pass < 2; ++pass) {
                const int col = pass * 512 + lane * 8;
                float cur[8], prv[8], mm[8], y[8];
                load8(prow + P_R + seg * 1024 + col, cur);
                if (t != 0) load8(prow - NP + P_R + seg * 1024 + col, prv); else {
#pragma unroll
                    for (int i = 0; i < 8; ++i) prv[i] = 0.f; }
                loadf8(mu + seg * 1024 + col, mm);
#pragma unroll
                for (int i = 0; i < 8; ++i) y[i] = cur[i] + (prv[i] - cur[i]) * mm[i];
                if (seg == 0) store8(rs_ + (size_t)m * 1024 + col, y);
                else if (seg == 2) store8(vs_ + (size_t)m * 1024 + col, y);
                else {
                    store8(ks_ + (size_t)m * 1024 + col, y);
                    float kk8[8], z[8]; loadf8(k_k + col, kk8);
                    float ss = 0.f;
#pragma unroll
                    for (int i = 0; i < 8; ++i) { z[i] = y[i] * kk8[i]; ss += z[i] * z[i]; }
                    ss = sum8(ss);
                    const float inv = 1.f / fmaxf(sqrtf(ss), 1e-12f);
#pragma unroll
                    for (int i = 0; i < 8; ++i) z[i] *= inv;
                    store8(kkb + (size_t)m * 1024 + col, z);
                }
            }
        {
            float cur[8], prv[8], mm[8], y[8];
            if (lane < 32) {
                const int which = lane >> 4, l = lane & 15;
                if (l < 12) {
                    const int pc = (which ? P_XA : P_XW) + l * 8, mc = (which ? 3168 : 3072) + l * 8;
                    load8(prow + pc, cur);
                    if (t != 0) load8(prow - NP + pc, prv); else {
#pragma unroll
                        for (int i = 0; i < 8; ++i) prv[i] = 0.f; }
                    loadf8(mu + mc, mm);
#pragma unroll
                    for (int i = 0; i < 8; ++i) { const float v = cur[i] + (prv[i] - cur[i]) * mm[i]; y[i] = which ? v : (1.f - 2.f / (__expf(2.f * v) + 1.f)); }
                } else {
#pragma unroll
                    for (int i = 0; i < 8; ++i) y[i] = 0.f;
                }
                store8(acat + (size_t)m * 512 + which * 128 + l * 8, y);
            } else {
                const int l = lane - 32;
                load8(prow + P_XG + l * 8, cur);
                if (t != 0) load8(prow - NP + P_XG + l * 8, prv); else {
#pragma unroll
                    for (int i = 0; i < 8; ++i) prv[i] = 0.f; }
                loadf8(mu + 3264 + l * 8, mm);
#pragma unroll
                for (int i = 0; i < 8; ++i) { const float v = cur[i] + (prv[i] - cur[i]) * mm[i]; y[i] = fsigmoid(v); }
                store8(acat + (size_t)m * 512 + 256 + l * 8, y);
            }
        }
    }
}


typedef float f32x4m __attribute__((ext_vector_type(4)));
__device__ __forceinline__ unsigned fkey(float f) { const unsigned u = __builtin_bit_cast(unsigned, f); return u ^ ((unsigned)((int)u >> 31) | 0x80000000u); }
__device__ __forceinline__ int sum16_i(int x) {
    x += __builtin_amdgcn_update_dpp(0, x, 0xB1, 0xf, 0xf, true); x += __builtin_amdgcn_update_dpp(0, x, 0x4E, 0xf, 0xf, true);
    x += __builtin_amdgcn_update_dpp(0, x, 0x141, 0xf, 0xf, true); x += __builtin_amdgcn_update_dpp(0, x, 0x140, 0xf, 0xf, true); return x; }
__device__ __forceinline__ int wave_sum_i(int x) { x = sum16_i(x);
    return __builtin_amdgcn_readlane(x, 0) + __builtin_amdgcn_readlane(x, 16) + __builtin_amdgcn_readlane(x, 32) + __builtin_amdgcn_readlane(x, 48); }
__device__ __forceinline__ void phase_x1(Frame& F, const Params& P) {
    const int lane = F.lane;
    const int gw = F.bid * NWAVES + F.wave;
    const int NGW = F.G * NWAVES;
    LAS float* srow = (LAS float*)(F.lds + F.wave * 16384);
    const bf16* proj = (const bf16*)(F.ws + WS_PROJ);
    const float* iwf = (const float*)(F.ws + WS_IWF);
    u64* mask = (u64*)(F.ws + WS_MASK);
    for (int j = gw; j < SEQ / 2; j += NGW)
        for (int qi = 0; qi < 4; ++qi) {
            const int b = qi >> 1, t = (qi & 1) ? (SEQ - 1 - j) : j, m = b * SEQ + t;
            u64* mrow = mask + (size_t)m * 64;
            if (t < TOPK) {
                const int lo = 64 * lane;
                const u64 w = t >= lo + 63 ? ~0ull : (t < lo ? 0ull : ((2ull << (t - lo)) - 1ull));
                mrow[lane] = w;
                continue;
            }
            const bf16* qrow = proj + (size_t)m * NP + P_IQ + (lane & 15) * 64 + 8 * (lane >> 4);
            const s8v a0 = *(const s8v*)qrow, a1 = *(const s8v*)(qrow + 32);
            const v4f w4 = *(const v4f*)(iwf + (size_t)m * 16 + 4 * (lane >> 4));
            const int ng = (t >> 6) + 1;
            const bf16* kbase = proj + (size_t)(b * SEQ + (lane & 15)) * NP + P_IK + 8 * (lane >> 4);
            for (int g = 0; g < ng; ++g) {
                float sc[4];
#pragma unroll
                for (int tt = 0; tt < 4; ++tt) {
                    const bf16* kp = kbase + (size_t)(64 * g + 16 * tt) * NP;
                    const s8v b0 = *(const s8v*)kp, b1 = *(const s8v*)(kp + 32);
                    f32x4m acc = (f32x4m){0.f, 0.f, 0.f, 0.f};
                    acc = __builtin_amdgcn_mfma_f32_16x16x32_bf16(a0, b0, acc, 0, 0, 0);
                    acc = __builtin_amdgcn_mfma_f32_16x16x32_bf16(a1, b1, acc, 0, 0, 0);
                    sc[tt] = w4.x * fmaxf(acc[0], 0.f) + w4.y * fmaxf(acc[1], 0.f) + w4.z * fmaxf(acc[2], 0.f) + w4.w * fmaxf(acc[3], 0.f);
                }
#pragma unroll
                for (int tt = 0; tt < 4; ++tt) { sc[tt] += __shfl_xor(sc[tt], 16); sc[tt] += __shfl_xor(sc[tt], 32); }
                const int lg = lane >> 4;
                float mine = lg == 0 ? sc[0] : (lg == 1 ? sc[1] : (lg == 2 ? sc[2] : sc[3]));
                if (64 * g + lane > t) mine = -__builtin_inff();
                srow[64 * g + lane] = mine;
            }
            LDS_WAIT();
            unsigned key[64];
#pragma unroll
            for (int jj = 0; jj < 64; ++jj) { float v = -__builtin_inff(); if (jj < ng) v = srow[64 * jj + lane]; key[jj] = fkey(v); }
            unsigned prefix = 0u;
            for (int bit = 31; bit >= 0; --bit) {
                const unsigned cand = prefix | (1u << bit);
                int pc = 0;
#pragma unroll
                for (int jj = 0; jj < 64; ++jj) pc += key[jj] >= cand ? 1 : 0;
                const int cnt = wave_sum_i(pc);
                if (cnt >= TOPK) prefix = cand;
                if (cnt == TOPK) break;
            }
            u64 myw = 0ull;
            for (int jj = 0; jj < ng; ++jj) { const u64 bal = __ballot(fkey(srow[64 * jj + lane]) >= prefix); if (lane == jj) myw = bal; }
            mrow[lane] = myw;
            LDS_WAIT();
        }
}

namespace att {
using bf16x8 = __attribute__((ext_vector_type(8))) short;
using s16x4  = __attribute__((ext_vector_type(4))) short;
using f32x16 = __attribute__((ext_vector_type(16))) float;
using u32x4  = __attribute__((ext_vector_type(4))) unsigned;
constexpr int D = 128, NW = 8, QBLK = 32, KVBLK = 64;
constexpr float SCALE = 0.088388347648318440f;
constexpr float THR = 8.f;
#ifndef ATT_SDEPTH
#define ATT_SDEPTH 1
#endif
constexpr int SDEPTH = ATT_SDEPTH;
constexpr int LDQ = NP, LDK = NP, LDO = 1024;
constexpr size_t SHM_V = KVBLK * D * 2, SHM_K = KVBLK * D * 2, SHM_ATTN = 2 * SHM_V + 2 * SHM_K + NW * 64 * 4;
#define KSWZ(row, colB) ((row) * 256 + ((colB) ^ (((row) & 7) << 4)))
#define SBAR() __builtin_amdgcn_sched_barrier(0)
__device__ __forceinline__ int crow(int r, int hi) { return (r & 3) + 8 * (r >> 2) + 4 * hi; }
__device__ __forceinline__ unsigned cvtpk(float lo, float hi) { unsigned r; asm volatile("v_cvt_pk_bf16_f32 %0, %1, %2" : "=v"(r) : "v"(lo), "v"(hi)); return r; }
__device__ __forceinline__ void partialSM(f32x16& p0, f32x16& p1, float& m_reg, float& mn, float& alpha) {
  constexpr float C = SCALE * 1.4426950408889634f;
  float pmax = p0[0]; for (int r = 1; r < 16; ++r) pmax = fmaxf(pmax, p0[r]); for (int r = 0; r < 16; ++r) pmax = fmaxf(pmax, p1[r]);
  { auto rr = __builtin_amdgcn_permlane32_swap(__float_as_uint(pmax), __float_as_uint(pmax), false, false);
    pmax = fmaxf(__uint_as_float(rr[0]), __uint_as_float(rr[1])); }
  if (__builtin_expect(__all(pmax - m_reg <= THR / SCALE), 1)) { mn = m_reg; alpha = 1.f; }
  else { mn = fmaxf(m_reg, pmax); alpha = __builtin_amdgcn_exp2f((m_reg - mn) * C); m_reg = mn; }
  float mnC = -mn * C;
  for (int r = 0; r < 16; ++r) p0[r] = fmaf(p0[r], C, mnC); for (int r = 0; r < 16; ++r) p1[r] = fmaf(p1[r], C, mnC);
  for (int r = 0; r < 16; ++r) p0[r] = __builtin_amdgcn_exp2f(p0[r]);
}
template <int POS> __device__ __forceinline__ void maskp(float& p, unsigned w) {
  unsigned tmp; asm volatile("v_bfe_i32 %1, %2, %3, 1\n\tv_and_b32 %0, %0, %1" : "+v"(p), "=&v"(tmp) : "v"(w), "n"(POS)); }
__device__ __forceinline__ void finishSM(f32x16& p0, f32x16& p1, float alpha, float& l_reg, bf16x8& pa0, bf16x8& pa1, bf16x8& pa2, bf16x8& pa3, unsigned w0, unsigned w1) {
  for (int r = 0; r < 16; ++r) p1[r] = __builtin_amdgcn_exp2f(p1[r]);
#define MSK(R) do { float t0 = p0[R], t1 = p1[R]; maskp<((R) & 3) + 8 * ((R) >> 2)>(t0, w0); maskp<((R) & 3) + 8 * ((R) >> 2)>(t1, w1); p0[R] = t0; p1[R] = t1; } while (0)
  MSK(0); MSK(1); MSK(2); MSK(3); MSK(4); MSK(5); MSK(6); MSK(7); MSK(8); MSK(9); MSK(10); MSK(11); MSK(12); MSK(13); MSK(14); MSK(15);
#undef MSK
  float ps = 0; for (int r = 0; r < 16; ++r) ps += p0[r]; for (int r = 0; r < 16; ++r) ps += p1[r];
  { auto rr = __builtin_amdgcn_permlane32_swap(__float_as_uint(ps), __float_as_uint(ps), false, false);
    ps = __uint_as_float(rr[0]) + __uint_as_float(rr[1]); }
  l_reg = l_reg * alpha + ps;
#define PK4(P, BASE, OUT) do { unsigned a0 = cvtpk(P[BASE + 0], P[BASE + 1]), a1 = cvtpk(P[BASE + 2], P[BASE + 3]);   \
    unsigned b0 = cvtpk(P[BASE + 4], P[BASE + 5]), b1 = cvtpk(P[BASE + 6], P[BASE + 7]);                              \
    auto r0 = __builtin_amdgcn_permlane32_swap(a0, b0, false, false); auto r1 = __builtin_amdgcn_permlane32_swap(a1, b1, false, false); \
    u32x4 w = {r0[0], r1[0], r0[1], r1[1]}; OUT = *reinterpret_cast<bf16x8*>(&w); } while (0)
  PK4(p0, 0, pa0); PK4(p0, 8, pa1); PK4(p1, 0, pa2); PK4(p1, 8, pa3);
#undef PK4
}
__device__ __forceinline__ void qkt(f32x16& p0, f32x16& p1, const bf16* Ks, const char* qr, int r32, int hi) {
  p0 = f32x16{}; p1 = f32x16{};
  for (int d0 = 0; d0 < 8; ++d0) { int cb = (d0 * 16 + hi * 8) * 2;
    bf16x8 b0 = *reinterpret_cast<const bf16x8*>((const char*)Ks + KSWZ(r32, cb));
    bf16x8 b1 = *reinterpret_cast<const bf16x8*>((const char*)Ks + KSWZ(32 + r32, cb));
    bf16x8 q = *reinterpret_cast<const bf16x8*>(qr + d0 * 1024);
    p0 = __builtin_amdgcn_mfma_f32_32x32x16_bf16(b0, q, p0, 0, 0, 0);
    p1 = __builtin_amdgcn_mfma_f32_32x32x16_bf16(b1, q, p1, 0, 0, 0); }
}
__device__ __forceinline__ int v_st(int k, int c) { const int kk = (k & ~0xC) | ((k & 4) << 1) | ((k & 8) >> 1); return ((kk >> 3) * 4 + (c >> 5)) * 512 + ((kk & 7) * 32 + (c & 31)) * 2; }
__device__ __forceinline__ int v_rd_base(int lane) { return ((lane & 3) << 3) | (((lane >> 2) & 3) << 6) | (((lane >> 4) & 1) << 5) | (((lane >> 5) & 1) << 8); }
constexpr int v_rd_off(int d0, int ks, int half) { return d0 * 512 + ks * 4096 + half * 2048; }
template <int OFF> __device__ __forceinline__ s16x4 tr_read(int vb) {
  s16x4 r; asm volatile("ds_read_b64_tr_b16 %0, %1 offset:%2" : "=&v"(r) : "v"(vb), "i"(OFF) : "memory"); return r;
}
template <int D0> __device__ __forceinline__ void pv_one(f32x16& od, int vb, bf16x8 pa0, bf16x8 pa1, bf16x8 pa2, bf16x8 pa3) {
  const s16x4 l0 = tr_read<v_rd_off(D0, 0, 0)>(vb), h0 = tr_read<v_rd_off(D0, 0, 1)>(vb), l1 = tr_read<v_rd_off(D0, 1, 0)>(vb), h1 = tr_read<v_rd_off(D0, 1, 1)>(vb);
  const s16x4 l2 = tr_read<v_rd_off(D0, 2, 0)>(vb), h2 = tr_read<v_rd_off(D0, 2, 1)>(vb), l3 = tr_read<v_rd_off(D0, 3, 0)>(vb), h3 = tr_read<v_rd_off(D0, 3, 1)>(vb);
  asm volatile("s_waitcnt lgkmcnt(0)" ::: "memory"); SBAR();
#define PK(L, H) (bf16x8){L[0], L[1], L[2], L[3], H[0], H[1], H[2], H[3]}
  od = __builtin_amdgcn_mfma_f32_32x32x16_bf16(pa0, PK(l0, h0), od, 0, 0, 0);
  od = __builtin_amdgcn_mfma_f32_32x32x16_bf16(pa1, PK(l1, h1), od, 0, 0, 0);
  od = __builtin_amdgcn_mfma_f32_32x32x16_bf16(pa2, PK(l2, h2), od, 0, 0, 0);
  od = __builtin_amdgcn_mfma_f32_32x32x16_bf16(pa3, PK(l3, h3), od, 0, 0, 0);
#undef PK
}
__device__ __forceinline__ void pv_d0(f32x16* o, int vb, bf16x8 pa0, bf16x8 pa1, bf16x8 pa2, bf16x8 pa3) {
  pv_one<0>(o[0], vb, pa0, pa1, pa2, pa3); pv_one<1>(o[1], vb, pa0, pa1, pa2, pa3); pv_one<2>(o[2], vb, pa0, pa1, pa2, pa3); pv_one<3>(o[3], vb, pa0, pa1, pa2, pa3);
}
__device__ __forceinline__ void attn_masked_body(const bf16* __restrict__ Qb, const bf16* __restrict__ Kh, const bf16* __restrict__ Vh, const u64* __restrict__ Mq,
                                                 float* __restrict__ Ob, int seq, char* lds) {
  const int tid = threadIdx.x, wid = tid >> 6, lane = tid & 63, r32 = lane & 31, hi = lane >> 5;
  bf16* V_lds = (bf16*)lds; bf16* K_lds = (bf16*)(lds + 2 * SHM_V);
  float* ws = (float*)(lds + 2 * SHM_V + 2 * SHM_K) + wid * 64; float* li_l = ws; float* al_l = ws + 32;
  float m_reg = -1e30f, l_reg = 0; f32x16 o[4] = {};
  const bf16* Qw = Qb + (long)(wid * QBLK + r32) * LDQ + hi * 8;
  const u64* Mw = Mq + (long)(wid * QBLK + r32) * 64;
  char* qr = lds + SHM_ATTN + wid * 8192 + lane * 16;
#pragma unroll
  for (int d0 = 0; d0 < 8; ++d0) *reinterpret_cast<bf16x8*>(qr + d0 * 1024) = *reinterpret_cast<const bf16x8*>(Qw + d0 * 16);
  const int sr = tid >> 4, sc = (tid & 15) * 8, vst0 = v_st(sr, sc), vst1 = v_st(32 + sr, sc);
  const int vb0 = (int)(uintptr_t)V_lds + v_rd_base(lane);
  struct { bf16x8 vs0, vs1, ks0, ks1; } sr_[SDEPTH];
#define SLOAD(i, k0) do { sr_[i].vs0 = *reinterpret_cast<const bf16x8*>(&Vh[(long)((k0) + sr) * LDK + sc]); sr_[i].vs1 = *reinterpret_cast<const bf16x8*>(&Vh[(long)((k0) + 32 + sr) * LDK + sc]); \
    sr_[i].ks0 = *reinterpret_cast<const bf16x8*>(&Kh[(long)((k0) + sr) * LDK + sc]); sr_[i].ks1 = *reinterpret_cast<const bf16x8*>(&Kh[(long)((k0) + 32 + sr) * LDK + sc]); } while (0)
#define SWRITE(b, i) do { *(bf16x8*)((char*)V_lds + (b) * SHM_V + vst0) = sr_[i].vs0;          \
    *(bf16x8*)((char*)V_lds + (b) * SHM_V + vst1) = sr_[i].vs1; int kc = sc * 2;               \
    *(bf16x8*)((char*)K_lds + (b) * SHM_K + KSWZ(sr, kc)) = sr_[i].ks0;                       \
    *(bf16x8*)((char*)K_lds + (b) * SHM_K + KSWZ(32 + sr, kc)) = sr_[i].ks1; } while (0)
#define SWAIT() do { if constexpr (SDEPTH == 2) asm volatile("s_waitcnt vmcnt(4)" ::: "memory"); else asm volatile("s_waitcnt vmcnt(0)" ::: "memory"); } while (0)
#define RESC(a) do { if (__any((a) < 1.f)) { if (hi == 0) al_l[r32] = (a); asm volatile("s_waitcnt lgkmcnt(0)" ::: "memory"); \
    for (int d = 0; d < 4; ++d) for (int r = 0; r < 16; ++r) o[d][r] *= al_l[crow(r, hi)]; } } while (0)
#define MW0(mk) ((unsigned)(mk) >> (4 * hi))
#define MW1(mk) ((unsigned)((mk) >> 32) >> (4 * hi))
  f32x16 pA0, pA1, pB0, pB1; float mnA, mnB, alA, alB; bf16x8 pa0, pa1, pa2, pa3; const int NT = seq / KVBLK;
  u64 mkA, mkB;
  constexpr int SE = 0, SO = SDEPTH - 1;
  SLOAD(SE, 0); asm volatile("s_waitcnt vmcnt(0)" ::: "memory"); SWRITE(0, SE); __syncthreads();
  mkA = Mw[0];
  qkt(pA0, pA1, K_lds, qr, r32, hi); partialSM(pA0, pA1, m_reg, mnA, alA);
  SLOAD(SO, KVBLK); if constexpr (SDEPTH == 2) { if (2 < NT) SLOAD(SE, 2 * KVBLK); }
  SWAIT(); SWRITE(1, SO); __syncthreads();
  for (int j = 1; j + 1 < NT; j += 2) {
    mkB = Mw[j];
    SBAR(); qkt(pB0, pB1, (bf16*)((char*)K_lds + SHM_K), qr, r32, hi);
    finishSM(pA0, pA1, alA, l_reg, pa0, pa1, pa2, pa3, MW0(mkA), MW1(mkA)); SBAR();
    SLOAD(SO, (j + SDEPTH) * KVBLK); SBAR();
    pv_d0(o, vb0, pa0, pa1, pa2, pa3); partialSM(pB0, pB1, m_reg, mnB, alB);
    __syncthreads(); SWAIT(); SWRITE(0, SE);
    RESC(alB); __syncthreads();
    mkA = Mw[j + 1];
    SBAR(); qkt(pA0, pA1, K_lds, qr, r32, hi);
    finishSM(pB0, pB1, alB, l_reg, pa0, pa1, pa2, pa3, MW0(mkB), MW1(mkB)); SBAR();
    if (SDEPTH == 1 || j + 3 < NT) SLOAD(SE, (j + 1 + SDEPTH) * KVBLK); SBAR();
    pv_d0(o, vb0 + (int)SHM_V, pa0, pa1, pa2, pa3); partialSM(pA0, pA1, m_reg, mnA, alA);
    __syncthreads(); SWAIT(); SWRITE(1, SO);
    RESC(alA); __syncthreads();
  }
  mkB = Mw[NT - 1];
  SBAR(); qkt(pB0, pB1, (bf16*)((char*)K_lds + SHM_K), qr, r32, hi);
  finishSM(pA0, pA1, alA, l_reg, pa0, pa1, pa2, pa3, MW0(mkA), MW1(mkA)); SBAR();
  pv_d0(o, vb0, pa0, pa1, pa2, pa3); partialSM(pB0, pB1, m_reg, mnB, alB);
  __syncthreads(); RESC(alB);
  finishSM(pB0, pB1, alB, l_reg, pa0, pa1, pa2, pa3, MW0(mkB), MW1(mkB)); SBAR();
  pv_d0(o, vb0 + (int)SHM_V, pa0, pa1, pa2, pa3);
  if (hi == 0) li_l[r32] = l_reg; asm volatile("s_waitcnt lgkmcnt(0)" ::: "memory");
  float rli[16];
#pragma unroll
  for (int r = 0; r < 16; ++r) rli[r] = __builtin_amdgcn_rcpf(li_l[crow(r, hi)]);
  float* Ow = Ob + (long)(wid * QBLK) * LDO;
#pragma unroll
  for (int r = 0; r < 16; ++r) { int orow = crow(r, hi);
    for (int d0 = 0; d0 < 4; ++d0) Ow[(long)orow * LDO + d0 * 32 + r32] = o[d0][r] * rli[r]; }
  __syncthreads();
#undef SLOAD
#undef SWRITE
#undef SWAIT
#undef RESC
#undef MW0
#undef MW1
}
#undef KSWZ
#undef SBAR
}

__device__ __forceinline__ void phase_attn(Frame& F, const Params& P, int aslot) {
    const int bh = aslot >> 3, i = aslot & 7, b = bh >> 3, h = bh & 7;
    const bf16* proj = (const bf16*)(F.ws + WS_PROJ);
    const u64* mask = (const u64*)(F.ws + WS_MASK);
    float* attout = (float*)(F.ws + WS_ATT);
    for (int u = 0; u < 2; ++u) {
        const int qb = u ? (15 - i) : i;
        const size_t m0 = (size_t)b * SEQ + (size_t)qb * 256;
        att::attn_masked_body(proj + m0 * NP + P_Q + h * 128, proj + (size_t)b * SEQ * NP + P_K + h * 128, proj + (size_t)b * SEQ * NP + P_V + h * 128,
                              mask + m0 * 64, attout + m0 * 1024 + h * 128, (qb + 1) * 256, (char*)F.lds);
    }
}


constexpr int SC_CH = 32, SC_NCH = SEQ / SC_CH;
constexpr int SC_W = 0, SC_KK = 8192, SC_BT = 16384, SC_KP = 24576, SC_R = 32768, SC_V = 40960, SC_O = 43008, SC_BUF = 45056;
__device__ __forceinline__ void scan_stage(Frame& F, const Params& P, int b, int h, int qd, int c, LAS unsigned char* buf) {
    const int li = F.tid - 256, s = li >> 3, kg = li & 7;
    const size_t m = (size_t)b * SEQ + (size_t)c * SC_CH + s; const int col = h * 64 + 8 * kg;
    const bf16* rs_ = (const bf16*)(F.ws + WS_RS); const bf16* ks_ = (const bf16*)(F.ws + WS_KS); const bf16* vs_ = (const bf16*)(F.ws + WS_VS);
    const bf16* kkb = (const bf16*)(F.ws + WS_KK); const bf16* ab = (const bf16*)(F.ws + WS_A); const float* decay = (const float*)((const unsigned char*)F.out + OUT_DECAY);
    float r8[8], k8[8], kk8[8], a8[8], d8[8], ka8[8], v8[8];
    load8(rs_ + m * 1024 + col, r8); load8(ks_ + m * 1024 + col, k8); load8(kkb + m * 1024 + col, kk8); load8(ab + m * 1024 + col, a8);
    loadf8(decay + m * 1024 + col, d8); loadf8(P.in[IN_KA] + col, ka8);
    if (kg < 2) load8(vs_ + m * 1024 + h * 64 + 16 * qd + 8 * kg, v8);
    float bt8[8], kp8[8];
#pragma unroll
    for (int i = 0; i < 8; ++i) { bt8[i] = kk8[i] * a8[i]; kp8[i] = k8[i] * (1.f + (a8[i] - 1.f) * ka8[i]); }
    const int o = s * 256 + kg * 32;
    *(LAS v4f*)(buf + SC_W + o) = (v4f){d8[0], d8[1], d8[2], d8[3]};   *(LAS v4f*)(buf + SC_W + o + 16) = (v4f){d8[4], d8[5], d8[6], d8[7]};
    *(LAS v4f*)(buf + SC_KK + o) = (v4f){kk8[0], kk8[1], kk8[2], kk8[3]}; *(LAS v4f*)(buf + SC_KK + o + 16) = (v4f){kk8[4], kk8[5], kk8[6], kk8[7]};
    *(LAS v4f*)(buf + SC_BT + o) = (v4f){bt8[0], bt8[1], bt8[2], bt8[3]}; *(LAS v4f*)(buf + SC_BT + o + 16) = (v4f){bt8[4], bt8[5], bt8[6], bt8[7]};
    *(LAS v4f*)(buf + SC_KP + o) = (v4f){kp8[0], kp8[1], kp8[2], kp8[3]}; *(LAS v4f*)(buf + SC_KP + o + 16) = (v4f){kp8[4], kp8[5], kp8[6], kp8[7]};
    *(LAS v4f*)(buf + SC_R + o) = (v4f){r8[0], r8[1], r8[2], r8[3]};   *(LAS v4f*)(buf + SC_R + o + 16) = (v4f){r8[4], r8[5], r8[6], r8[7]};
    if (kg < 2) { *(LAS v4f*)(buf + SC_V + s * 64 + kg * 32) = (v4f){v8[0], v8[1], v8[2], v8[3]}; *(LAS v4f*)(buf + SC_V + s * 64 + kg * 32 + 16) = (v4f){v8[4], v8[5], v8[6], v8[7]}; }
}
__device__ __forceinline__ void scan_flush(Frame& F, const Params& P, int b, int h, int qd, int c, const LAS unsigned char* buf) {
    const int li = F.tid - 256;
    if (li < 128) { const int s = li >> 2, q4 = li & 3;
        float* obuf = (float*)((unsigned char*)F.out + OUT_O);
        const v4f v = *(const LAS v4f*)(buf + SC_O + s * 64 + q4 * 16);
        *(v4f*)(obuf + ((size_t)b * SEQ + (size_t)c * SC_CH + s) * 1024 + h * 64 + 16 * qd + 4 * q4) = v; }
}
__device__ __forceinline__ void phase_scan(Frame& F, const Params& P, int sslot) {
    const int pair = sslot >> 2, qd = sslot & 3, b = pair >> 4, h = pair & 15;
    const bool loader = F.wave >= 4;
    const int g = F.lane >> 4, e = F.lane & 15, rowl = (F.wave & 3) * 4 + g;
    float S0 = 0.f, S1 = 0.f, S2 = 0.f, S3 = 0.f;
    if (loader) scan_stage(F, P, b, h, qd, 0, F.lds);
    __syncthreads();
    for (int c = 0; c < SC_NCH; ++c) {
        LAS unsigned char* cur = F.lds + (c & 1) * SC_BUF; LAS unsigned char* nxt = F.lds + ((c + 1) & 1) * SC_BUF;
        if (loader) {
            if (c + 1 < SC_NCH) scan_stage(F, P, b, h, qd, c + 1, nxt);
            if (c >= 1) scan_flush(F, P, b, h, qd, c - 1, nxt);
        } else {
#pragma unroll 4
            for (int s = 0; s < SC_CH; ++s) {
                const v4f w4 = *(const LAS v4f*)(cur + SC_W + s * 256 + e * 16), kk4 = *(const LAS v4f*)(cur + SC_KK + s * 256 + e * 16), bt4 = *(const LAS v4f*)(cur + SC_BT + s * 256 + e * 16);
                const v4f kp4 = *(const LAS v4f*)(cur + SC_KP + s * 256 + e * 16), r4 = *(const LAS v4f*)(cur + SC_R + s * 256 + e * 16);
                const float vv = *(const LAS float*)(cur + SC_V + s * 64 + rowl * 4);
                float p = (S0 * kk4.x + S1 * kk4.y) + (S2 * kk4.z + S3 * kk4.w);
                p = sum16(p);
                const float sa = -p;
                S0 = S0 * w4.x + (sa * bt4.x + vv * kp4.x);
                S1 = S1 * w4.y + (sa * bt4.y + vv * kp4.y);
                S2 = S2 * w4.z + (sa * bt4.z + vv * kp4.z);
                S3 = S3 * w4.w + (sa * bt4.w + vv * kp4.w);
                float q = (S0 * r4.x + S1 * r4.y) + (S2 * r4.z + S3 * r4.w);
                q = sum16(q);
                if (e == 0) *(LAS float*)(cur + SC_O + s * 64 + rowl * 4) = q;
            }
        }
        __syncthreads();
    }
    if (loader) scan_flush(F, P, b, h, qd, SC_NCH - 1, F.lds + ((SC_NCH - 1) & 1) * SC_BUF);
    __syncthreads();
}

__device__ __forceinline__ void phase_p5a(Frame& F, const Params& P) {
    const int gw = F.bid * NWAVES + F.wave, NGW = F.G * NWAVES, lane = F.lane;
    const float* att = (const float*)(F.ws + WS_ATT); bf16* mix = (bf16*)(F.ws + WS_ATT);
    const float* obuf = (const float*)((const unsigned char*)F.out + OUT_O);
    const bf16* rs_ = (const bf16*)(F.ws + WS_RS); const bf16* ks_ = (const bf16*)(F.ws + WS_KS); const bf16* vs_ = (const bf16*)(F.ws + WS_VS);
    const bf16* ab = (const bf16*)(F.ws + WS_A); const bf16* gb = (const bf16*)(F.ws + WS_G);
    const float* k_a = P.in[IN_KA]; const float* r_k = P.in[IN_RK]; const float* lng = P.in[IN_LNG]; const float* lnb = P.in[IN_LNB];
    for (int m = gw; m < T; m += NGW) {
        v4f av[4];
#pragma unroll
        for (int j = 0; j < 4; ++j) av[j] = *(const v4f*)(att + (size_t)m * 1024 + 256 * j + 4 * lane);
        float outv[2][8];
#pragma unroll
        for (int pass = 0; pass < 2; ++pass) {
            const int col = pass * 512 + lane * 8;
            float o8[8], r8[8], k8[8], v8[8], a8[8], g8[8], ka8[8], rk8[8], lg8[8], lb8[8];
            loadf8(obuf + (size_t)m * 1024 + col, o8);
            load8(rs_ + (size_t)m * 1024 + col, r8); load8(ks_ + (size_t)m * 1024 + col, k8); load8(vs_ + (size_t)m * 1024 + col, v8);
            load8(ab + (size_t)m * 1024 + col, a8); load8(gb + (size_t)m * 1024 + col, g8);
            loadf8(k_a + col, ka8); loadf8(r_k + col, rk8); loadf8(lng + col, lg8); loadf8(lnb + col, lb8);
            float s = 0.f;
#pragma unroll
            for (int i = 0; i < 8; ++i) s += o8[i];
            const float mean = sum8(s) * (1.f / 64.f);
            float s2 = 0.f, bp = 0.f;
#pragma unroll
            for (int i = 0; i < 8; ++i) { o8[i] -= mean; s2 += o8[i] * o8[i]; const float kp = k8[i] * (1.f + (a8[i] - 1.f) * ka8[i]); bp += r8[i] * kp * rk8[i]; }
            const float rstd = 1.f / sqrtf(sum8(s2) * (1.f / 64.f) + 64e-5f);
            const float bonus = sum8(bp);
#pragma unroll
            for (int i = 0; i < 8; ++i) outv[pass][i] = ((o8[i] * rstd) * lg8[i] + lb8[i] + bonus * v8[i]) * g8[i];
        }
        asm volatile("s_waitcnt vmcnt(0)" ::: "memory");
#pragma unroll
        for (int j = 0; j < 4; ++j) { v2u w; w.x = pk2(av[j].x, av[j].y); w.y = pk2(av[j].z, av[j].w); *(v2u*)(mix + (size_t)m * 2048 + 256 * j + 4 * lane) = w; }
#pragma unroll
        for (int pass = 0; pass < 2; ++pass) store8(mix + (size_t)m * 2048 + 1024 + pass * 512 + lane * 8, outv[pass]);
    }
}


#ifndef MK_ONE_LAUNCH
#define MK_ONE_LAUNCH 0
#endif
constexpr int NPH = 11;

__global__ void __launch_bounds__(NTHREADS, 2) mk_fwd(Params p) {
    extern __shared__ __attribute__((aligned(16))) unsigned char lds[];
    Frame F;
    F.lds = (LAS unsigned char*)lds;
    F.tid = threadIdx.x; F.lane = F.tid & 63; F.wave = __builtin_amdgcn_readfirstlane(F.tid >> 6);
    F.bid = blockIdx.x; F.G = gridDim.x;
    F.out = p.out; F.ws = p.ws;
    volatile LAS unsigned* MISC = (volatile LAS unsigned*)(F.lds + MISC_OFF);
    for (int u = F.tid; u < (LDS_BYTES - LDSCTL_OFF) / 4; u += NTHREADS) ((LAS unsigned*)(F.lds + LDSCTL_OFF))[u] = 0u;
    __syncthreads();
    const int lo = p.ph_lo, hi = p.ph_hi;
#if MK_ONE_LAUNCH
    XcdBarrier bar = xcd_barrier_post((unsigned*)(F.ws + WS_CTL) + 4096, MISC + 8);
    cg::grid_group grid = cg::this_grid();
#define GRID_BAR() xcd_barrier(bar)
#else
#define GRID_BAR() do {} while (0)
#endif
#ifndef PH_MASK
#define PH_MASK 0x7FF
#endif
#define IN(k) ((((PH_MASK) >> (k)) & 1) && lo <= (k) && (k) < hi)
#define BOTH(k) (IN(k) && IN((k) + 1))

    if (IN(0)) { phase_p0(F, p); if (BOTH(0)) {
#if MK_ONE_LAUNCH
        grid.sync();
#endif
    } }
    if (IN(1)) { phase_p1(F, p); if (BOTH(1)) GRID_BAR(); }
    if (IN(2)) {
        pg8::Gemm g{(const bf16*)(F.ws + WS_H), (const bf16*)(F.ws + WS_WIN), T, NP, DM}; pg8::StaticOrder S; S.init(T, NP, F.G, F.bid);
        pg8::EpiStore E{(bf16*)(F.ws + WS_PROJ), NP};
        pg8::gemm_phase<pg8::EpiStore, pg8::StaticOrder, true, true>(F.lds, g, S, E);
        if (BOTH(2)) GRID_BAR();
    }
    if (IN(3)) { phase_p3a(F, p); if (BOTH(3)) GRID_BAR(); }
    if (IN(4)) {
        pg8::Gemm g{(const bf16*)(F.ws + WS_ACAT), (const bf16*)(F.ws + WS_LORAT), T, 3072, 512}; pg8::StaticOrder S; S.init(T, 3072, F.G, F.bid);
        pg8::EpiLora E{(float*)((unsigned char*)F.out + OUT_DECAY), (bf16*)(F.ws + WS_A), (bf16*)(F.ws + WS_G), p.in[IN_W0], p.in[IN_A0]};
        pg8::gemm_phase<pg8::EpiLora, pg8::StaticOrder, true, true>(F.lds, g, S, E);
        phase_x1(F, p);
        if (BOTH(4)) GRID_BAR();
    }
    if (IN(5)) {
        const int xcd = F.bid & 7, slot = F.bid >> 3;
        #ifndef X2_ONLY
#define X2_ONLY 3
#endif
        if (slot < 16) { if (X2_ONLY & 1) phase_attn(F, p, xcd * 16 + slot); } else { if (X2_ONLY & 2) phase_scan(F, p, xcd * 16 + (slot - 16)); }
        if (BOTH(5)) GRID_BAR();
    }
    if (IN(6)) { phase_p5a(F, p); if (BOTH(6)) GRID_BAR(); }
    if (IN(7)) {
        pg8::Gemm g{(const bf16*)(F.ws + WS_ATT), (const bf16*)(F.ws + WS_WOUT), T, DM, DM}; pg8::StaticOrder S; S.init(T, DM, F.G, F.bid);
        pg8::EpiRes E{p.in[IN_X], F.out, (const float*)(F.ws + WS_MODV) + 2 * DM, NMOD};
        pg8::gemm_phase<pg8::EpiRes, pg8::StaticOrder, true, true>(F.lds, g, S, E);
        if (BOTH(7)) GRID_BAR();
    }
    if (IN(8)) { phase_p6(F, p); if (BOTH(8)) GRID_BAR(); }
    if (IN(9)) {
        pg8::Gemm g{(const bf16*)(F.ws + WS_H), (const bf16*)(F.ws + WS_WGU), T, 2 * DFF, DM}; pg8::StaticOrder S; S.init(T, 2 * DFF, F.G, F.bid);
        pg8::EpiSwiGLU E{(bf16*)(F.ws + WS_ACT), DFF};
        pg8::gemm_phase<pg8::EpiSwiGLU, pg8::StaticOrder, true, true>(F.lds, g, S, E);
        if (BOTH(9)) GRID_BAR();
    }
    if (IN(10)) {
        pg8::Gemm g{(const bf16*)(F.ws + WS_ACT), (const bf16*)(F.ws + WS_WDOWN), T, DM, DFF}; pg8::StaticOrder S; S.init(T, DM, F.G, F.bid);
        pg8::EpiRes E{F.out, F.out, (const float*)(F.ws + WS_MODV) + 5 * DM, NMOD};
        pg8::gemm_phase<pg8::EpiRes, pg8::StaticOrder, true, true>(F.lds, g, S, E);
    }
#undef IN
#undef BOTH
}

extern "C" void kernel_launch(void* const* d_in, const int* in_sizes, int n_in, void* d_out, int out_size, void* d_ws, size_t ws_size, hipStream_t stream) {
    static int ok = 0;
    if (ok == 0) {
        if (n_in != 25 || in_sizes[0] != T * DM || out_size != T * DM || ws_size < WS_END) {
            fprintf(stderr, "kernel_launch: unexpected shapes: n_in %d in0 %d out %d ws %zu (need >= %zu); nothing launched\n", n_in, n_in > 0 ? in_sizes[0] : -1, out_size, ws_size, (size_t)WS_END);
            ok = -1; return; }
        if (hipFuncSetAttribute((const void*)mk_fwd, hipFuncAttributeMaxDynamicSharedMemorySize, LDS_BYTES) != hipSuccess) { fprintf(stderr, "kernel_launch: hipFuncSetAttribute failed\n"); ok = -1; return; }
        ok = 1;
    }
    if (ok < 0) return;
    (void)hipMemsetAsync((char*)d_ws + WS_CTL, 0, CTL_ZERO_BYTES, stream);
    Params a{};
    for (int i = 0; i < 25; ++i) a.in[i] = (const float*)d_in[i];
    a.out = (float*)d_out; a.ws = (unsigned char*)d_ws;
#if MK_ONE_LAUNCH
    a.ph_lo = 0; a.ph_hi = NPH;
    void* args[] = {&a};
    hipError_t e = hipLaunchCooperativeKernel((const void*)mk_fwd, dim3(256), dim3(NTHREADS), args, LDS_BYTES, stream);
    if (e != hipSuccess) fprintf(stderr, "kernel_launch: cooperative launch failed: %s\n", hipGetErrorString(e));
#else
    for (int k = 0; k < NPH; ++k) {
        a.ph_lo = k; a.ph_hi = k + 1;
        hipLaunchKernelGGL(mk_fwd, dim3(256), dim3(NTHREADS), LDS_BYTES, stream, a);
    }
    const hipError_t le = hipPeekAtLastError();
    if (le != hipSuccess) fprintf(stderr, "kernel_launch: launch failed: %s\n", hipGetErrorName(le));
#endif
}
```
